# Optimizing an MI355X kernel written in HIP

```python
import math
import jax, jax.numpy as jnp
from jax import lax
import numpy as np

D_MODEL = 1024
BATCH = 16
SEQ = 2048
DEPTH = 4
DEC_BATCH = 32
DEC_SEQ = 64
PAST_LEN = 1024

CHUNK = 64
N_A_LAYERS = DEPTH // 2
N_B_LAYERS = DEPTH - N_A_LAYERS
SSM_EXPAND = 2
D_INNER = SSM_EXPAND * D_MODEL
SSM_HEAD_DIM = 64
SSM_HEADS = D_INNER // SSM_HEAD_DIM
SSM_GROUPS = 4
HEADS_PER_GROUP = SSM_HEADS // SSM_GROUPS
SSM_STATE = 128
D_CONV = 4
CONV_DIM = D_INNER + 2 * SSM_GROUPS * SSM_STATE
IN_DIM = D_INNER + CONV_DIM + SSM_HEADS
SSD_CHUNK = CHUNK
RMS_EPS = 1e-5
ATT_HEAD_DIM = 64
ATT_HEADS = D_MODEL // ATT_HEAD_DIM
ATT_WIDTH = ATT_HEADS * ATT_HEAD_DIM
ATT_SCALE = ATT_HEAD_DIM ** -0.5
Q_BLOCK = 128
FORGET_BIAS_INIT = 3.0
PEER_HEADS = 8
PEER_NKEYS = 128
PEER_EXPERTS = PEER_NKEYS * PEER_NKEYS
PEER_QDIM = 256
PEER_HALF = PEER_QDIM // 2
PEER_TOPK = 16
PEER_TOK_BLOCK = 256
DN_ALPHA = (2.0 * DEPTH) ** 0.25
DN_BETA = (8.0 * DEPTH) ** -0.25
LN_EPS = 1e-5

kernel_name = "yoco_mamba2_fox_peer_stream_step"


def layer_norm(x, g, b):
    xf = x.astype(jnp.float32)
    mu = jnp.mean(xf, -1, keepdims=True)
    var = jnp.mean(jnp.square(xf - mu), -1, keepdims=True)
    return ((xf - mu) * lax.rsqrt(var + LN_EPS) * g.astype(jnp.float32) + b.astype(jnp.float32)).astype(x.dtype)


def gated_group_rms_norm(y, z, w):
    shp = y.shape
    h = (y * jax.nn.silu(z)).astype(jnp.float32).reshape(shp[:-1] + (SSM_GROUPS, D_INNER // SSM_GROUPS))
    h = h * lax.rsqrt(jnp.mean(h * h, -1, keepdims=True) + RMS_EPS)
    return (h.reshape(shp) * w.astype(jnp.float32)).astype(y.dtype)


def causal_dwconv(u, conv_state, w, b):
    L = u.shape[1]
    ext = jnp.concatenate([conv_state.astype(u.dtype), u], axis=1)
    out = b.astype(u.dtype) + ext[:, 0:L] * w[0]
    for k in range(1, D_CONV):
        out = out + ext[:, k:k + L] * w[k]
    return out, ext[:, L:]


def segsum(a):
    T = a.shape[-1]
    cs = jnp.cumsum(a, -1)
    diff = cs[..., :, None] - cs[..., None, :]
    mask = jnp.tril(jnp.ones((T, T), dtype=bool))
    return jnp.where(mask, diff, -jnp.inf)


def ssd_scan(x, a, Bm, Cm, init_state):
    b, L, G, R, P = x.shape
    N = Bm.shape[-1]
    Q = min(SSD_CHUNK, L)
    nc = L // Q
    xc = x.reshape(b, nc, Q, G, R, P)
    Bc = Bm.reshape(b, nc, Q, G, N)
    Cc = Cm.reshape(b, nc, Q, G, N)
    ac = a.reshape(b, nc, Q, G, R).transpose(0, 3, 4, 1, 2)
    a_cs = jnp.cumsum(ac, -1)
    Lmat = jnp.exp(segsum(ac))
    CB = jnp.einsum("bclgn,bcsgn->bcgls", Cc, Bc)
    y_diag = jnp.einsum("bcgls,bgrcls,bcsgrp->bclgrp", CB, Lmat, xc)
    decay_states = jnp.exp(a_cs[..., -1:] - a_cs)
    chunk_states = jnp.einsum("bclgn,bgrcl,bclgrp->bcgrpn", Bc, decay_states, xc)
    chunk_decay = jnp.exp(a_cs[..., -1])

    def step(h, inp):
        s_c, d_c = inp
        return h * d_c[..., None, None] + s_c, h

    final, states_in = lax.scan(step, init_state,
                                (jnp.moveaxis(chunk_states, 1, 0), jnp.moveaxis(chunk_decay, 3, 0)))
    states_in = jnp.moveaxis(states_in, 0, 1)
    y_off = jnp.einsum("bclgn,bcgrpn,bgrcl->bclgrp", Cc, states_in, jnp.exp(a_cs))
    return (y_diag + y_off).reshape(b, L, G, R, P), final


def mamba2_mixer(x, conv_state, ssm_state, w_in, conv_w, conv_b, dt_bias, A_log, D_skip, norm_w, w_out):
    f32 = jnp.float32
    b, L, _ = x.shape
    z, xBC, dt = jnp.split(x @ w_in, [D_INNER, D_INNER + CONV_DIM], axis=-1)
    xBC, new_conv = causal_dwconv(xBC, conv_state, conv_w, conv_b)
    xBC = jax.nn.silu(xBC)
    xs, Bm, Cm = jnp.split(xBC, [D_INNER, D_INNER + SSM_GROUPS * SSM_STATE], axis=-1)
    xs = xs.reshape(b, L, SSM_GROUPS, HEADS_PER_GROUP, SSM_HEAD_DIM).astype(f32)
    Bm = Bm.reshape(b, L, SSM_GROUPS, SSM_STATE).astype(f32)
    Cm = Cm.reshape(b, L, SSM_GROUPS, SSM_STATE).astype(f32)
    dt = jax.nn.softplus(dt.astype(f32) + dt_bias.astype(f32)).reshape(b, L, SSM_GROUPS, HEADS_PER_GROUP)
    A = -jnp.exp(A_log.astype(f32)).reshape(SSM_GROUPS, HEADS_PER_GROUP)
    h0 = ssm_state.astype(f32).reshape(b, SSM_GROUPS, HEADS_PER_GROUP, SSM_HEAD_DIM, SSM_STATE)
    y, h_final = ssd_scan(xs * dt[..., None], dt * A, Bm, Cm, h0)
    y = y + xs * D_skip.astype(f32).reshape(SSM_GROUPS, HEADS_PER_GROUP)[:, :, None]
    y = gated_group_rms_norm(y.reshape(b, L, D_INNER).astype(x.dtype), z, norm_w)
    return y @ w_out, new_conv, h_final.reshape(b, SSM_HEADS, SSM_HEAD_DIM, SSM_STATE)


def shared_kv(h, kv_w, kv_b_f):
    b, L, _ = h.shape
    k, v, f = jnp.split(h @ kv_w, [ATT_WIDTH, 2 * ATT_WIDTH], axis=-1)
    logf = jax.nn.log_sigmoid(f.astype(jnp.float32) + kv_b_f.astype(jnp.float32))
    return (k.reshape(b, L, ATT_HEADS, ATT_HEAD_DIM), v.reshape(b, L, ATT_HEADS, ATT_HEAD_DIM), logf)


def forgetting_attention(q, cq, qpos, k, v, ck, kpos):
    s = jnp.einsum("bqhd,bkhd->bhqk", q, k).astype(jnp.float32) * ATT_SCALE
    s = s + jnp.transpose(cq, (0, 2, 1))[..., :, None] - jnp.transpose(ck, (0, 2, 1))[..., None, :]
    mask = kpos[None, :] <= qpos[:, None]
    p = jax.nn.softmax(jnp.where(mask, s, -jnp.inf), axis=-1).astype(v.dtype)
    return jnp.einsum("bhqk,bkhd->bqhd", p, v)


def fox_mixer(x, k, v, ck, w_qg, w_o):
    b, L, _ = x.shape
    Lk = k.shape[1]
    q, g = jnp.split(x @ w_qg, 2, axis=-1)
    q = q.reshape(b, L, ATT_HEADS, ATT_HEAD_DIM)
    kpos = jnp.arange(Lk)
    qpos = (Lk - L) + jnp.arange(L)
    cq = ck[:, Lk - L:]
    if L > Q_BLOCK:
        nb = L // Q_BLOCK
        qb = q.reshape(b, nb, Q_BLOCK, ATT_HEADS, ATT_HEAD_DIM).swapaxes(0, 1)
        cqb = cq.reshape(b, nb, Q_BLOCK, ATT_HEADS).swapaxes(0, 1)
        pb = qpos.reshape(nb, Q_BLOCK)
        o = lax.map(lambda a: forgetting_attention(a[0], a[1], a[2], k, v, ck, kpos), (qb, cqb, pb))
        o = o.swapaxes(0, 1).reshape(b, L, ATT_HEADS, ATT_HEAD_DIM)
    else:
        o = forgetting_attention(q, cq, qpos, k, v, ck, kpos)
    o = o.reshape(b, L, ATT_WIDTH) * jax.nn.sigmoid(g)
    return o @ w_o


def peer_ffn(x, w_q, subkeys, u_tab, v_tab):
    shp = x.shape
    xt = x.reshape(-1, D_MODEL)
    T = xt.shape[0]
    q = (xt @ w_q).reshape(T, PEER_HEADS, 2, PEER_HALF)
    s = jnp.einsum("thkd,knd->thkn", q, subkeys).astype(jnp.float32)
    sv, si = lax.top_k(s, PEER_TOPK)
    cand = sv[..., 0, :, None] + sv[..., 1, None, :]
    best, bi = lax.top_k(cand.reshape(T, PEER_HEADS, PEER_TOPK * PEER_TOPK), PEER_TOPK)
    i1 = jnp.take_along_axis(si[..., 0, :], bi // PEER_TOPK, axis=-1)
    i2 = jnp.take_along_axis(si[..., 1, :], bi % PEER_TOPK, axis=-1)
    experts = (i1 * PEER_NKEYS + i2).reshape(T, PEER_HEADS * PEER_TOPK)
    gates = jax.nn.softmax(best, axis=-1).reshape(T, PEER_HEADS * PEER_TOPK)
    nblk = -(-T // PEER_TOK_BLOCK)
    pad = nblk * PEER_TOK_BLOCK - T
    hk = PEER_HEADS * PEER_TOPK
    xp = jnp.pad(xt, ((0, pad), (0, 0))).reshape(nblk, PEER_TOK_BLOCK, D_MODEL)
    ep = jnp.pad(experts, ((0, pad), (0, 0))).reshape(nblk, PEER_TOK_BLOCK, hk)
    gp = jnp.pad(gates, ((0, pad), (0, 0))).reshape(nblk, PEER_TOK_BLOCK, hk)

    def block(args):
        xb, eb, gb = args
        u = jnp.take(u_tab, eb, axis=0)
        act = jax.nn.gelu(jnp.einsum("tkd,td->tk", u, xb).astype(jnp.float32), approximate=False) * gb
        vv = jnp.take(v_tab, eb, axis=0)
        return jnp.einsum("tk,tkd->td", act.astype(xb.dtype), vv)

    out = lax.map(block, (xp, ep, gp)).reshape(nblk * PEER_TOK_BLOCK, D_MODEL)[:T]
    return out.reshape(shp)


def trunk(x, conv_state, ssm_state, past_k, past_v, past_logf,
          a_w_in, a_conv_w, a_conv_b, a_dt_bias, a_A_log, a_D, a_norm_w, a_w_out,
          kv_w, kv_b_f, b_w_qg, b_w_o, peer_w_q, peer_subkeys, peer_u, peer_v, ln_g, ln_b):
    new_conv, new_ssm = [], []
    for i in range(DEPTH):
        if i < N_A_LAYERS:
            y, c_i, s_i = mamba2_mixer(x, conv_state[i], ssm_state[i], a_w_in[i], a_conv_w[i], a_conv_b[i],
                                       a_dt_bias[i], a_A_log[i], a_D[i], a_norm_w[i], a_w_out[i])
            new_conv.append(c_i)
            new_ssm.append(s_i)
        else:
            j = i - N_A_LAYERS
            y = fox_mixer(x, k_all, v_all, ck, b_w_qg[j], b_w_o[j])
        x = layer_norm(DN_ALPHA * x + y, ln_g[i, 0], ln_b[i, 0])
        x = layer_norm(DN_ALPHA * x + peer_ffn(x, peer_w_q[i], peer_subkeys[i], peer_u[i], peer_v[i]),
                       ln_g[i, 1], ln_b[i, 1])
        if i == N_A_LAYERS - 1:
            k_new, v_new, logf_new = shared_kv(x, kv_w, kv_b_f)
            k_all = jnp.concatenate([past_k.astype(k_new.dtype), k_new], axis=1)
            v_all = jnp.concatenate([past_v.astype(v_new.dtype), v_new], axis=1)
            ck = jnp.cumsum(jnp.concatenate([past_logf.astype(jnp.float32), logf_new], axis=1), axis=1)
    return x, jnp.stack(new_conv), jnp.stack(new_ssm), k_new, v_new, logf_new


def setup_inputs(seed: int = 0) -> dict:
    key = jax.random.key(seed)
    ks = jax.random.split(key, 32)
    f32 = jnp.float32

    def nrm(k, shape, scale):
        return jax.random.normal(k, shape, f32) * scale

    dt0 = jnp.exp(jax.random.uniform(ks[10], (N_A_LAYERS, SSM_HEADS), f32, math.log(1e-3), math.log(1e-1)))
    kv_w = nrm(ks[17], (D_MODEL, 2 * ATT_WIDTH + ATT_HEADS), D_MODEL ** -0.5)
    kv_w = kv_w.at[:, ATT_WIDTH:2 * ATT_WIDTH].multiply(DN_BETA)
    return {
        "x_prompt": nrm(ks[0], (BATCH, SEQ, D_MODEL), 1.0),
        "x_sample": nrm(ks[1], (DEC_BATCH, DEC_SEQ, D_MODEL), 1.0),
        "state_ssm": nrm(ks[2], (N_A_LAYERS, DEC_BATCH, SSM_HEADS, SSM_HEAD_DIM, SSM_STATE), 0.1),
        "state_conv": nrm(ks[3], (N_A_LAYERS, DEC_BATCH, D_CONV - 1, CONV_DIM), 1.0),
        "cache_k": nrm(ks[4], (DEC_BATCH, PAST_LEN, ATT_HEADS, ATT_HEAD_DIM), 1.0),
        "cache_v": nrm(ks[5], (DEC_BATCH, PAST_LEN, ATT_HEADS, ATT_HEAD_DIM), DN_BETA),
        "cache_logf": jax.nn.log_sigmoid(FORGET_BIAS_INIT + nrm(ks[6], (DEC_BATCH, PAST_LEN, ATT_HEADS), 1.0)),
        "a_w_in": nrm(ks[7], (N_A_LAYERS, D_MODEL, IN_DIM), D_MODEL ** -0.5),
        "a_conv_w": nrm(ks[8], (N_A_LAYERS, D_CONV, CONV_DIM), D_CONV ** -0.5),
        "a_conv_b": nrm(ks[9], (N_A_LAYERS, CONV_DIM), 0.02),
        "a_dt_bias": dt0 + jnp.log(-jnp.expm1(-dt0)),
        "a_A_log": jnp.log(jax.random.uniform(ks[11], (N_A_LAYERS, SSM_HEADS), f32, 1.0, 16.0)),
        "a_D": 1.0 + nrm(ks[12], (N_A_LAYERS, SSM_HEADS), 0.1),
        "a_norm_w": 1.0 + nrm(ks[13], (N_A_LAYERS, D_INNER), 0.02),
        "a_w_out": nrm(ks[14], (N_A_LAYERS, D_INNER, D_MODEL), DN_BETA * D_INNER ** -0.5),
        "kv_w": kv_w,
        "kv_b_f": FORGET_BIAS_INIT + nrm(ks[15], (ATT_HEADS,), 0.1),
        "b_w_qg": nrm(ks[16], (N_B_LAYERS, D_MODEL, 2 * ATT_WIDTH), D_MODEL ** -0.5),
        "b_w_o": nrm(ks[18], (N_B_LAYERS, ATT_WIDTH, D_MODEL), DN_BETA * ATT_WIDTH ** -0.5),
        "peer_w_q": nrm(ks[19], (DEPTH, D_MODEL, PEER_HEADS * PEER_QDIM), D_MODEL ** -0.5),
        "peer_subkeys": nrm(ks[20], (DEPTH, 2, PEER_NKEYS, PEER_HALF), PEER_HALF ** -0.5),
        "peer_u": nrm(ks[21], (DEPTH, PEER_EXPERTS, D_MODEL), D_MODEL ** -0.5),
        "peer_v": nrm(ks[22], (DEPTH, PEER_EXPERTS, D_MODEL), DN_BETA * PEER_HEADS ** -0.5),
        "ln_g": 1.0 + nrm(ks[23], (DEPTH, 2, D_MODEL), 0.02),
        "ln_b": nrm(ks[24], (DEPTH, 2, D_MODEL), 0.02),
    }


def reference(x_prompt, x_sample, state_ssm, state_conv, cache_k, cache_v, cache_logf,
              a_w_in, a_conv_w, a_conv_b, a_dt_bias, a_A_log, a_D, a_norm_w, a_w_out,
              kv_w, kv_b_f, b_w_qg, b_w_o, peer_w_q, peer_subkeys, peer_u, peer_v, ln_g, ln_b):
    bp = x_prompt.shape[0]
    dt = x_prompt.dtype
    conv0 = jnp.zeros((N_A_LAYERS, bp, D_CONV - 1, CONV_DIM), dt)
    ssm0 = jnp.zeros((N_A_LAYERS, bp, SSM_HEADS, SSM_HEAD_DIM, SSM_STATE), jnp.float32)
    k0 = jnp.zeros((bp, 0, ATT_HEADS, ATT_HEAD_DIM), dt)
    f0 = jnp.zeros((bp, 0, ATT_HEADS), jnp.float32)
    y_prompt, p_conv, p_ssm, p_k, p_v, p_logf = trunk(
        x_prompt, conv0, ssm0, k0, k0, f0,
        a_w_in, a_conv_w, a_conv_b, a_dt_bias, a_A_log, a_D, a_norm_w, a_w_out,
        kv_w, kv_b_f, b_w_qg, b_w_o, peer_w_q, peer_subkeys, peer_u, peer_v, ln_g, ln_b)
    y_sample, s_conv, s_ssm, s_k, s_v, s_logf = trunk(
        x_sample, state_conv, state_ssm, cache_k, cache_v, cache_logf,
        a_w_in, a_conv_w, a_conv_b, a_dt_bias, a_A_log, a_D, a_norm_w, a_w_out,
        kv_w, kv_b_f, b_w_qg, b_w_o, peer_w_q, peer_subkeys, peer_u, peer_v, ln_g, ln_b)
    return (y_prompt, y_sample, p_ssm, p_conv, p_k, p_v, p_logf, s_ssm, s_conv, s_k, s_v, s_logf)
```

```cpp
#include <hip/hip_runtime.h>
#include <cstdio>
#include <cstdint>
namespace pg8 {
#define PG8_LAS __attribute__((address_space(3)))
typedef unsigned short bf16_t;
typedef short bf16x8 __attribute__((ext_vector_type(8)));
typedef float f32x4 __attribute__((ext_vector_type(4)));
typedef unsigned u32x4 __attribute__((ext_vector_type(4)));
constexpr int BM = 256, BK = 64, HALF = 128, HTB = HALF * BK * 2  , STAGE_BYTES = 8 * HTB, NXCD = 8, WGM = 8;

__host__ __device__ __forceinline__ int lds_byte(int r, int c) { const int st = (r >> 4) * 2 + (c >> 5), rr = r & 15, cc = c & 31, ob = rr * 64 + cc * 2; return st * 1024 + (ob ^ (((ob >> 9) & 1) << 5)); }
__host__ __device__ __forceinline__ void stage_rc(int b, int& R, int& C) { const int st = b / 1024, sb = b % 1024, swz = sb ^ (((sb >> 9) & 1) << 5); R = (st >> 1) * 16 + swz / 64; C = (st & 1) * 32 + (swz % 64) / 2; }
__host__ __device__ __forceinline__ int perm32(int rho) { const int n = rho >> 4, i = rho & 15; return 8 * (i >> 2) + 4 * n + (i & 3); }

struct Unit { int pm, pn; };
struct Gemm { const bf16_t* A; const bf16_t* Bt; int M, N, K; };

struct StaticOrder {
    int nM, nN, nwg, G, c;
    __host__ __device__ void init(int M, int N, int G_, int c_) { nM = M / BM; nN = N / BM; nwg = nM * nN; G = G_; c = c_; }
    __host__ __device__ bool next(int i, Unit& u) const {
        const long L = (long)i * G + c; if (L >= nwg) return false;
        int wgid = (int)L; { const int q = nwg / NXCD, r = nwg % NXCD, xcd = wgid % NXCD, off = wgid / NXCD; wgid = (xcd < r ? xcd * (q + 1) : r * (q + 1) + (xcd - r) * q) + off; }
        const int nig = WGM * nN, gid = wgid / nig, fm = gid * WGM, gsz = (nM - fm) < WGM ? (nM - fm) : WGM;
        u.pm = fm + ((wgid % nig) % gsz); u.pn = (wgid % nig) / gsz; return true;
    }
    __device__ __forceinline__ void a_ready(const Unit&) const {}
    __device__ __forceinline__ void done(const Unit&) const {}
};

__device__ __forceinline__ unsigned cvt_pk_bf16(float lo, float hi) { unsigned r; asm volatile("v_cvt_pk_bf16_f32 %0, %1, %2" : "=v"(r) : "v"(lo), "v"(hi)); return r; }
typedef float f32x2 __attribute__((ext_vector_type(2)));
__device__ __forceinline__ f32x2 gelu_pk(f32x2 v) {
    const f32x2 av = __builtin_elementwise_abs(v), d = av * 0.2316418882f + 1.0f;
    f32x2 t; t.x = __builtin_amdgcn_rcpf(d.x); t.y = __builtin_amdgcn_rcpf(d.y);
    f32x2 q = t * 0.5307027145f + (-0.7265760135f); q = q * t + 0.7107068705f; q = q * t + (-0.142248368f); q = q * t + 0.127414796f; q = q * t;
    const f32x2 s = (v * v) * (-0.72134752044f);
    f32x2 e; e.x = __builtin_amdgcn_exp2f(s.x); e.y = __builtin_amdgcn_exp2f(s.y);
    const f32x2 m = v * (q * e), r = v - m;
    f32x2 o; o.x = v.x < 0.f ? m.x : r.x; o.y = v.y < 0.f ? m.y : r.y; return o;
}

template <int ACT  > struct EpiBf16 {
    static constexpr bool PERM = true, AFTER_DRAIN = false; static_assert(ACT == 0 || ACT == 1, "EpiBf16: ACT is 0 (none) or 1 (gelu_pk)");
    bf16_t* O; int ldc; const float* bias; int split_cols; size_t split_stride; float scale0;
    __device__ __forceinline__ void operator()(const f32x4 (&acc)[2][2][4][2], const Unit& u, int wr, int wc, int fr, int fq) const {
        const int row0 = u.pm * BM + wr * 64 + fr; int colt = u.pn * BM; bf16_t* base = O;
        float sc = 1.f; if (split_cols) { const int t = colt / split_cols; base += (size_t)t * split_stride; colt -= t * split_cols; if (t == 0) sc = scale0; }
        const int col0 = colt + wc * 32 + 8 * fq, bcol0 = u.pn * BM + wc * 32 + 8 * fq;
        f32x4 bv[2][2];
#pragma unroll
        for (int bj = 0; bj < 2; ++bj)
#pragma unroll
            for (int n = 0; n < 2; ++n) bv[bj][n] = bias ? *(const f32x4*)(bias + bcol0 + bj * HALF + 4 * n) : (f32x4){0.f, 0.f, 0.f, 0.f};
#pragma unroll
        for (int ai = 0; ai < 2; ++ai)
#pragma unroll
            for (int m = 0; m < 4; ++m) { bf16_t* rowp = base + (size_t)(row0 + ai * HALF + m * 16) * ldc + col0;
#pragma unroll
                for (int bj = 0; bj < 2; ++bj) { f32x4 v0 = acc[ai][bj][m][0] + bv[bj][0], v1 = acc[ai][bj][m][1] + bv[bj][1];
                    if (ACT == 1) { f32x2 a = gelu_pk((f32x2){v0[0], v0[1]}), b = gelu_pk((f32x2){v0[2], v0[3]}), c = gelu_pk((f32x2){v1[0], v1[1]}), d = gelu_pk((f32x2){v1[2], v1[3]});
                        v0 = (f32x4){a.x, a.y, b.x, b.y}; v1 = (f32x4){c.x, c.y, d.x, d.y}; }
                    v0 = v0 * sc; v1 = v1 * sc; u32x4 w; w.x = cvt_pk_bf16(v0[0], v0[1]); w.y = cvt_pk_bf16(v0[2], v0[3]); w.z = cvt_pk_bf16(v1[0], v1[1]); w.w = cvt_pk_bf16(v1[2], v1[3]);
                    *(u32x4*)(rowp + bj * HALF) = w; } }
    }
};

struct EpiF32 {
    static constexpr bool PERM = false, AFTER_DRAIN = false;
    float* C; int ldc; const float* bias;
    __device__ __forceinline__ void operator()(const f32x4 (&acc)[2][2][4][2], const Unit& u, int wr, int wc, int fr, int fq) const {
        const int row0 = u.pm * BM + wr * 64 + fr, col0 = u.pn * BM + wc * 32 + 4 * fq;
        f32x4 bv[2][2];
#pragma unroll
        for (int bj = 0; bj < 2; ++bj)
#pragma unroll
            for (int n = 0; n < 2; ++n) bv[bj][n] = bias ? *(const f32x4*)(bias + col0 + bj * HALF + n * 16) : (f32x4){0.f, 0.f, 0.f, 0.f};
#pragma unroll
        for (int ai = 0; ai < 2; ++ai)
#pragma unroll
            for (int m = 0; m < 4; ++m) { float* rowp = C + (size_t)(row0 + ai * HALF + m * 16) * ldc + col0;
#pragma unroll
                for (int bj = 0; bj < 2; ++bj)
#pragma unroll
                    for (int n = 0; n < 2; ++n) *(f32x4*)(rowp + bj * HALF + n * 16) = acc[ai][bj][m][n] + bv[bj][n]; }
    }
};

template <class Epi, class Sched, bool ALIGN_EPI = false, bool SP2 = false>
__device__ __forceinline__ void gemm_phase(PG8_LAS unsigned char* lds, const Gemm g, const Sched& S, const Epi& E) {
    int tid_ = threadIdx.x; asm volatile("" : "+v"(tid_));
    const int tid = tid_, wid = __builtin_amdgcn_readfirstlane(tid >> 6), lane = tid & 63, wr = wid >> 2, wc = wid & 3, fr = lane & 15, fq = lane >> 4;
    const int K = g.K, nt = K / BK;
    unsigned voffA[2], voffB[2];
#pragma unroll
    for (int i = 0; i < 2; ++i) { int R, C; stage_rc(tid * 16 + i * 8192, R, C); const int Rb = Epi::PERM ? ((R & ~31) + perm32(R & 31)) : R;
        voffA[i] = (unsigned)(R * K + C) * 2u; voffB[i] = (unsigned)(Rb * K + C) * 2u; }
    const size_t kstep = (size_t)(BK * 2);
    const size_t hstep = (size_t)HALF * K * 2;
    const size_t tstep = 2 * hstep;
    const unsigned ldsw = (unsigned)wid * 1024u;
    const int aoff = lds_byte(wr * 64 + fr, fq * 8), boff = lds_byte(wc * 32 + fr, fq * 8);
#define PG8_SA(b, h) (((b) * 2 + (h)) * HTB)
#define PG8_SB(b, h) ((4 + (b) * 2 + (h)) * HTB)
#define PG8_STAGE(bufoff, gbase, voff) do { _Pragma("unroll") for (int _i = 0; _i < 2; ++_i) \
        __builtin_amdgcn_global_load_lds((const unsigned*)((const char*)(gbase) + (voff)[_i]), (PG8_LAS unsigned*)(lds + (bufoff) + ldsw + _i * 8192), 16, 0, 0); } while (0)
#define PG8_LDA(dst, b, h) do { _Pragma("unroll") for (int m = 0; m < 4; ++m) _Pragma("unroll") for (int k = 0; k < 2; ++k) dst[m][k] = *(const PG8_LAS bf16x8*)(lds + PG8_SA(b, h) + aoff + m * 2048 + k * 1024); } while (0)
#define PG8_LDB(dst, b, h) do { _Pragma("unroll") for (int n = 0; n < 2; ++n) _Pragma("unroll") for (int k = 0; k < 2; ++k) dst[n][k] = *(const PG8_LAS bf16x8*)(lds + PG8_SB(b, h) + boff + n * 2048 + k * 1024); } while (0)
#define PG8_MMA(ai, bj, At, Bt) do { __builtin_amdgcn_s_setprio(1); _Pragma("unroll") for (int m = 0; m < 4; ++m) _Pragma("unroll") for (int n = 0; n < 2; ++n) _Pragma("unroll") for (int k = 0; k < 2; ++k) \
        acc[ai][bj][m][n] = __builtin_amdgcn_mfma_f32_16x16x32_bf16(Bt[n][k], At[m][k], acc[ai][bj][m][n], 0, 0, 0); __builtin_amdgcn_s_setprio(0); } while (0)
#define PG8_WAIT_V(n) asm volatile("s_waitcnt vmcnt(" #n ")" ::: "memory")
#define PG8_WAIT_L(n) asm volatile("s_waitcnt lgkmcnt(" #n ")" ::: "memory")
#define PG8_BAR __builtin_amdgcn_s_barrier()
#define PG8_SCHED __builtin_amdgcn_sched_barrier(0)
    Unit cur, nxt; int ui = 0;
    if (!S.next(0, cur)) return;
    f32x4 acc[2][2][4][2];
#pragma unroll
    for (int a = 0; a < 2; ++a)
#pragma unroll
        for (int b = 0; b < 2; ++b)
#pragma unroll
            for (int m = 0; m < 4; ++m)
#pragma unroll
                for (int n = 0; n < 2; ++n) acc[a][b][m][n] = (f32x4){0.f, 0.f, 0.f, 0.f};
    bf16x8 At[4][2], B0[2][2], B1[2][2];
    const char* cA = (const char*)g.A + (size_t)cur.pm * tstep; const char* cB = (const char*)g.Bt + (size_t)cur.pn * tstep;
    S.a_ready(cur);
    if constexpr (SP2) {
        PG8_STAGE(PG8_SB(0, 0), cB, voffB); PG8_STAGE(PG8_SB(0, 1), cB + hstep, voffB); PG8_STAGE(PG8_SA(0, 0), cA, voffA); PG8_STAGE(PG8_SA(0, 1), cA + hstep, voffA);
        if (wr == 1) PG8_BAR;
        PG8_WAIT_V(2); PG8_BAR;
        PG8_STAGE(PG8_SB(1, 0), cB + kstep, voffB); PG8_STAGE(PG8_SA(1, 0), cA + kstep, voffA); PG8_STAGE(PG8_SB(1, 1), cB + hstep + kstep, voffB);
        PG8_WAIT_V(6); PG8_BAR;
    } else {
        PG8_STAGE(PG8_SB(0, 0), cB, voffB); PG8_STAGE(PG8_SA(0, 0), cA, voffA); PG8_STAGE(PG8_SB(0, 1), cB + hstep, voffB); PG8_STAGE(PG8_SA(0, 1), cA + hstep, voffA);
        if (wr == 1) PG8_BAR;
        PG8_WAIT_V(4); PG8_BAR;
        PG8_STAGE(PG8_SB(1, 0), cB + kstep, voffB); PG8_STAGE(PG8_SA(1, 0), cA + kstep, voffA); PG8_STAGE(PG8_SB(1, 1), cB + hstep + kstep, voffB);
        PG8_WAIT_V(6); PG8_BAR;
    }
    for (;;) {
        const bool has_next = S.next(ui + 1, nxt);
        const char* nA = has_next ? (const char*)g.A + (size_t)nxt.pm * tstep : cA; const char* nB = has_next ? (const char*)g.Bt + (size_t)nxt.pn * tstep : cB;
        for (int t = 0; t < nt; t += 2) {
            const bool last = (t == nt - 2);
            const char* a1 = cA + (size_t)(t + 1) * kstep;
            const char* a2 = last ? nA : cA + (size_t)(t + 2) * kstep; const char* b2 = last ? nB : cB + (size_t)(t + 2) * kstep;
            const char* a3 = a2 + kstep; const char* b3 = b2 + kstep;
            if (last && has_next) S.a_ready(nxt);
            if constexpr (SP2) {
            PG8_LDB(B0, 0, 0); PG8_LDB(B1, 0, 1); PG8_SCHED; PG8_LDA(At, 0, 0); PG8_STAGE(PG8_SA(1, 1), a1 + hstep, voffA);
            PG8_WAIT_V(8); PG8_WAIT_L(0); PG8_BAR; PG8_MMA(0, 0, At, B0); PG8_MMA(0, 1, At, B1); PG8_BAR; PG8_SCHED;
            PG8_LDA(At, 0, 1); PG8_STAGE(PG8_SB(0, 0), b2, voffB); PG8_STAGE(PG8_SB(0, 1), b2 + hstep, voffB); PG8_STAGE(PG8_SA(0, 0), a2, voffA);
            PG8_WAIT_V(8); PG8_WAIT_L(0); PG8_BAR; PG8_MMA(1, 0, At, B0); PG8_MMA(1, 1, At, B1); PG8_BAR; PG8_SCHED;
            PG8_LDB(B0, 1, 0); PG8_LDB(B1, 1, 1); PG8_SCHED; PG8_LDA(At, 1, 0); PG8_STAGE(PG8_SA(0, 1), a2 + hstep, voffA);
            PG8_WAIT_V(8); PG8_WAIT_L(0); PG8_BAR; PG8_MMA(0, 0, At, B0); PG8_MMA(0, 1, At, B1); PG8_BAR; PG8_SCHED;
            PG8_LDA(At, 1, 1); PG8_STAGE(PG8_SB(1, 0), b3, voffB); PG8_STAGE(PG8_SB(1, 1), b3 + hstep, voffB); PG8_STAGE(PG8_SA(1, 0), a3, voffA);
            PG8_WAIT_V(8); PG8_WAIT_L(0); PG8_BAR; PG8_MMA(1, 0, At, B0); PG8_MMA(1, 1, At, B1); PG8_BAR; PG8_SCHED;
            } else {
            PG8_LDB(B0, 0, 0); PG8_SCHED; PG8_LDA(At, 0, 0); PG8_STAGE(PG8_SA(1, 1), a1 + hstep, voffA);
            PG8_WAIT_L(8); PG8_BAR; PG8_WAIT_L(0); PG8_MMA(0, 0, At, B0); PG8_BAR; PG8_SCHED;
            PG8_LDB(B1, 0, 1); PG8_STAGE(PG8_SB(0, 0), b2, voffB);
            PG8_BAR; PG8_WAIT_L(0); PG8_MMA(0, 1, At, B1); PG8_BAR;
            PG8_LDA(At, 0, 1); PG8_STAGE(PG8_SA(0, 0), a2, voffA);
            PG8_BAR; PG8_WAIT_L(0); PG8_MMA(1, 0, At, B0); PG8_BAR; PG8_SCHED;
            PG8_STAGE(PG8_SB(0, 1), b2 + hstep, voffB);
            PG8_WAIT_V(6); PG8_BAR; PG8_MMA(1, 1, At, B1); PG8_BAR;
            PG8_LDB(B0, 1, 0); PG8_SCHED; PG8_LDA(At, 1, 0); PG8_STAGE(PG8_SA(0, 1), a2 + hstep, voffA);
            PG8_WAIT_L(8); PG8_BAR; PG8_WAIT_L(0); PG8_MMA(0, 0, At, B0); PG8_BAR; PG8_SCHED;
            PG8_LDB(B1, 1, 1); PG8_STAGE(PG8_SB(1, 0), b3, voffB);
            PG8_BAR; PG8_WAIT_L(0); PG8_MMA(0, 1, At, B1); PG8_BAR;
            PG8_LDA(At, 1, 1); PG8_STAGE(PG8_SA(1, 0), a3, voffA);
            PG8_BAR; PG8_WAIT_L(0); PG8_MMA(1, 0, At, B0); PG8_BAR; PG8_SCHED;
            PG8_STAGE(PG8_SB(1, 1), b3 + hstep, voffB);
            PG8_WAIT_V(6); PG8_BAR; PG8_MMA(1, 1, At, B1); PG8_BAR;
            }
        }
        if constexpr (ALIGN_EPI) { if (wr == 0) PG8_BAR; }
        if constexpr (!Epi::AFTER_DRAIN) { E(acc, cur, wr, wc, fr, fq); S.done(cur); }
        if (!has_next) break;
#pragma unroll
        for (int a = 0; a < 2; ++a)
#pragma unroll
            for (int b = 0; b < 2; ++b)
#pragma unroll
                for (int m = 0; m < 4; ++m)
#pragma unroll
                    for (int n = 0; n < 2; ++n) acc[a][b][m][n] = (f32x4){0.f, 0.f, 0.f, 0.f};
        cur = nxt; cA = nA; cB = nB; ++ui;
        if constexpr (ALIGN_EPI) { if (wr == 1) PG8_BAR; }
    }
    PG8_WAIT_V(0);
    if constexpr (!ALIGN_EPI) { if (wr == 0) PG8_BAR; }
    PG8_BAR;
    if constexpr (Epi::AFTER_DRAIN) { E.fused(acc, cur, wr, wc, fr, fq, lds, wid, lane); S.done(cur); }
#undef PG8_SA
#undef PG8_SB
#undef PG8_STAGE
#undef PG8_LDA
#undef PG8_LDB
#undef PG8_MMA
#undef PG8_WAIT_V
#undef PG8_WAIT_L
#undef PG8_BAR
#undef PG8_SCHED
}
}
#define GAS __attribute__((address_space(1)))
#define LAS __attribute__((address_space(3)))
typedef unsigned short bf16;
typedef unsigned v4u __attribute__((ext_vector_type(4)));
typedef float f32x4 __attribute__((ext_vector_type(4)));
typedef short bf16x8 __attribute__((ext_vector_type(8)));
typedef GAS unsigned gu32;
typedef GAS unsigned long long gu64;
#define RLX_AGENT __ATOMIC_RELAXED, __HIP_MEMORY_SCOPE_AGENT
#define LDS_WAIT() asm volatile("s_waitcnt lgkmcnt(0)" ::: "memory")
#define VM_WAIT() asm volatile("s_waitcnt vmcnt(0)" ::: "memory")
__device__ __forceinline__ unsigned long long rt() { return __builtin_amdgcn_s_memrealtime(); }
__device__ __forceinline__ unsigned f2bf(float f) { unsigned u = __builtin_bit_cast(unsigned, f); return (u + 0x7fffu + ((u >> 16) & 1u)) >> 16; }
__device__ __forceinline__ unsigned pk2(float lo, float hi) { return f2bf(lo) | (f2bf(hi) << 16); }
#define XB_TMO      128
#define XB_XCNT(j)  (256  + 64 * (j))
#define XB_XSUB(j)  (1280 + 64 * (j))
#define XB_XGEN(j)  (2304 + 64 * (j))
#define XB_TOP      3328
#define XB_TOPGEN   3392
#define XCD_BAR_WORDS 3456
#define XB_SPIN_CAP (1u << 24)

__device__ __forceinline__ unsigned xb_ld(unsigned* p)              { return __hip_atomic_load(p, __ATOMIC_RELAXED, __HIP_MEMORY_SCOPE_AGENT); }
__device__ __forceinline__ unsigned xb_add(unsigned* p, unsigned v) { return __hip_atomic_fetch_add(p, v, __ATOMIC_RELAXED, __HIP_MEMORY_SCOPE_AGENT); }
__device__ __forceinline__ unsigned xb_xcc_id() { return (unsigned)__builtin_amdgcn_s_getreg((3 << 11) | 20) & 0xFu; }
#define XB_SPIN(cond, bar) do { unsigned _sp = 0; while (cond) { __builtin_amdgcn_s_sleep(1); \
    if ((++_sp & 255u) == 0u) { if (xb_ld(&(bar)[XB_TMO])) break; if (_sp > XB_SPIN_CAP) { atomicAdd(&(bar)[XB_TMO], 1u); break; } } } } while (0)

struct XcdBarrier {
    unsigned* bar; unsigned x;
    volatile LAS unsigned* st;
};

__device__ __forceinline__ XcdBarrier xcd_barrier_post(unsigned* bar, volatile LAS unsigned* st) {
    XcdBarrier b; b.bar = bar; b.x = xb_xcc_id(); b.st = st;
    if (threadIdx.x == 0) (void)xb_add(&bar[XB_XCNT(b.x)], 1u);
    return b;
}
__device__ __forceinline__ void xcd_barrier_complete(unsigned* bar, unsigned x, unsigned& nloc, unsigned& nx) {
    const unsigned G = gridDim.x * gridDim.y * gridDim.z;
    unsigned sum, cnt, mine, sp = 0u;
    for (;;) {
        sum = 0u; cnt = 0u; mine = 0u;
#pragma unroll
        for (unsigned j = 0; j < 16; ++j) { const unsigned c = xb_ld(&bar[XB_XCNT(j)]); sum += c; cnt += (c > 0u) ? 1u : 0u; mine = (j == x) ? c : mine; }
        if (sum == G) break;
        __builtin_amdgcn_s_sleep(1);
        if ((++sp & 255u) == 0u) { if (xb_ld(&bar[XB_TMO])) break; if (sp > XB_SPIN_CAP) { atomicAdd(&bar[XB_TMO], 1u); break; } }
    }
    nloc = mine > 0u ? mine : 1u; nx = cnt > 0u ? cnt : 1u;
}

__device__ __forceinline__ void xcd_barrier(const XcdBarrier& b) {
    asm volatile("s_waitcnt vmcnt(0)" ::: "memory");
    __syncthreads();
    if (threadIdx.x == 0) {
        unsigned* bar = b.bar;
        __builtin_amdgcn_s_waitcnt(0);
        unsigned nloc = b.st[0], nx = b.st[1];
        if (nloc == 0u) { xcd_barrier_complete(bar, b.x, nloc, nx); b.st[0] = nloc; b.st[1] = nx; }
        const unsigned old = xb_add(&bar[XB_XSUB(b.x)], 1u);
        const unsigned gen = old / nloc;
        if (old + 1u == (gen + 1u) * nloc) {
            __builtin_amdgcn_fence(__ATOMIC_RELEASE, "agent");
            asm volatile("s_waitcnt vmcnt(0)" ::: "memory");
            const unsigned og = xb_add(&bar[XB_TOP], 1u);
            const unsigned tg = og / nx;
            if (og + 1u == (tg + 1u) * nx) xb_add(&bar[XB_TOPGEN], 1u);
            else XB_SPIN(xb_ld(&bar[XB_TOPGEN]) == tg, bar);
            __builtin_amdgcn_fence(__ATOMIC_ACQUIRE, "agent");
            xb_add(&bar[XB_XGEN(b.x)], 1u);
            asm volatile("s_waitcnt vmcnt(0)" ::: "memory");
        } else {
            XB_SPIN(xb_ld(&bar[XB_XGEN(b.x)]) == gen, bar);
            __builtin_amdgcn_fence(__ATOMIC_ACQUIRE, "agent");
            asm volatile("s_waitcnt vmcnt(0)" ::: "memory");
        }
    }
    __syncthreads();
}
constexpr int NWAVES = 8;
constexpr int DM = 1024;
constexpr int PB = 16, PL = 2048, SBT = 32, SL = 64, PAST = 1024, SKV = PAST + SL;
constexpr int TP = PB * PL, TS = SBT * SL, T = TP + TS;
constexpr int DIN = 2048, CONVD = 3072, NH = 32, NST = 128;
constexpr int IN_DIM = 5152, IN_PAD = 5376, ZXLD = 5120;
constexpr int KVN = 2064, KVPAD = 2304;
constexpr int AH = 16;
constexpr int NEXP = 16384;
constexpr float LN_EPS = 1e-5f, RMS_EPS = 1e-5f;
constexpr float DN_ALPHA = 1.6817928305074290f;
constexpr float ATT_SCALE = 0.125f;

constexpr size_t O_Y = 0, O_PSSM = 35651584, O_PCONV = 44040192, O_PK = 44335104, O_PV = 77889536, O_PLOGF = 111443968,
                 O_SSSM = 111968256, O_SCONV = 128745472, O_SK = 129335296, O_SV = 131432448, O_SLOGF = 133529600, O_END = 133562368;

constexpr size_t MiB = 1u << 20;
constexpr size_t WS_CTL = 0, CTL_ZERO_BYTES = 1 * MiB;
constexpr size_t WS_WIN = 2 * MiB;
constexpr size_t WS_WOUT = 23 * MiB;
constexpr size_t WS_WKV = 31 * MiB;
constexpr size_t WS_WQG = 36 * MiB;
constexpr size_t WS_WO = 44 * MiB;
constexpr size_t WS_WPQ = 48 * MiB;
constexpr size_t WS_SKT = 64 * MiB;
constexpr size_t WS_XB = 66 * MiB;
constexpr size_t WS_R1 = 134 * MiB;
constexpr size_t WS_PQ = WS_R1, WS_QB = WS_R1, WS_GB = WS_R1 + 68 * MiB, WS_OG = WS_R1 + 136 * MiB;
constexpr size_t WS_DT = 474 * MiB;
constexpr size_t WS_XC = 479 * MiB;
constexpr size_t WS_KB = WS_XC, WS_VB = WS_XC + 68 * MiB, WS_LOGF = WS_XC + 136 * MiB, WS_CKP = WS_XC + 139 * MiB, WS_CKS = WS_XC + 142 * MiB;
constexpr size_t WS_Y = 683 * MiB;
constexpr size_t WS_MIX = 819 * MiB;
constexpr size_t WS_EIDX = 955 * MiB;
constexpr size_t WS_GATE = 972 * MiB;
constexpr size_t WS_END = 989 * MiB;
static_assert(WS_WIN + (size_t)2 * IN_PAD * 1024 * 2 <= WS_WOUT && WS_WKV + (size_t)KVPAD * 1024 * 2 <= WS_WQG && WS_XB + (size_t)T * 1024 * 2 <= WS_R1, "ws map 1");
static_assert(WS_R1 + (size_t)T * ZXLD * 2 <= WS_DT && WS_DT + (size_t)T * 32 * 4 <= WS_XC && WS_XC + (size_t)T * CONVD * 2 <= WS_Y && WS_Y + (size_t)T * DIN * 2 <= WS_MIX, "ws map 2");
static_assert(WS_MIX + (size_t)T * 1024 * 4 <= WS_EIDX && WS_EIDX + (size_t)T * 128 * 4 <= WS_GATE && WS_GATE + (size_t)T * 128 * 4 <= WS_END, "ws map 3");
static_assert(WS_LOGF + (size_t)T * 16 * 4 <= WS_CKP && WS_CKP + (size_t)PB * PL * 16 * 4 <= WS_CKS && WS_CKS + (size_t)SBT * SKV * 16 * 4 <= WS_Y, "ws map 4");
constexpr int CW_TMO = 0, CW_CODE = 1, CW_BAR = 4096, MAX_BAR_REGIONS = 48;
static_assert((CW_BAR + MAX_BAR_REGIONS * XCD_BAR_WORDS) * 4 <= (int)CTL_ZERO_BYTES, "CTL words inside the memset region");

constexpr int RING_OFF = 0, RING_BYTES = 131072;
constexpr int LDSCTL_OFF = RING_BYTES, MISC_OFF = LDSCTL_OFF + 320;
constexpr int LDS_BYTES = 147456;

#define DI __device__ __forceinline__
DI float bf2f(unsigned short u) { return __uint_as_float(((unsigned)u) << 16); }
DI float bflo(unsigned w) { return __uint_as_float(w << 16); }
DI float bfhi(unsigned w) { return __uint_as_float(w & 0xffff0000u); }
DI float silu_f(float v) { return v / (1.f + __expf(-v)); }
DI float sigmoid_f(float v) { return 1.f / (1.f + __expf(-v)); }
DI float softplus_f(float v) { return v > 20.f ? v : log1pf(expf(v)); }
DI float logsigmoid_f(float v) { return v >= 0.f ? -log1pf(expf(-v)) : v - log1pf(expf(v)); }
DI float gelu_erf(float v) { return 0.5f * v * (1.f + erff(v * 0.70710678118654752f)); }
DI float wave_sum(float v) {
#pragma unroll
    for (int o = 1; o < 64; o <<= 1) v += __shfl_xor(v, o);
    return v;
}
DI float wave_max(float v) {
#pragma unroll
    for (int o = 1; o < 64; o <<= 1) v = fmaxf(v, __shfl_xor(v, o));
    return v;
}

struct Ctx {
    LAS unsigned char* lds;
    int tid, lane, wave, vcu, G, bx;
};
struct Args { const float* in[25]; float* out; unsigned char* ws; int ph_lo, ph_hi, li, pad; };
typedef const __attribute__((address_space(4))) Args* CArgs;
DI Ctx mkctx(LAS unsigned char* lds) {
    Ctx c; int tid = threadIdx.x, G = gridDim.x, bx = blockIdx.x; asm volatile("" : "+v"(tid), "+s"(G), "+s"(bx));
    c.lds = lds; c.tid = tid; c.lane = tid & 63; c.wave = __builtin_amdgcn_readfirstlane(tid >> 6); c.G = G; c.vcu = (G % 8 == 0) ? (bx % 8) * (G / 8) + bx / 8 : bx; c.bx = bx;
    return c;
}
DI CArgs kargs() { CArgs p = (CArgs)__builtin_amdgcn_kernarg_segment_ptr(); asm volatile("" : "+s"(p)); return p; }

namespace pg8 {
struct EpiInproj {
    static constexpr bool PERM = true, AFTER_DRAIN = false;
    bf16_t* ZX; float* DT;
    __device__ __forceinline__ void operator()(const f32x4 (&acc)[2][2][4][2], const Unit& u, int wr, int wc, int fr, int fq) const {
        const int row0 = u.pm * BM + wr * 64 + fr;
        if (u.pn < 20) {
            const int col0 = u.pn * BM + wc * 32 + 8 * fq;
#pragma unroll
            for (int ai = 0; ai < 2; ++ai)
#pragma unroll
                for (int m = 0; m < 4; ++m) { bf16_t* rowp = ZX + (size_t)(row0 + ai * HALF + m * 16) * ZXLD + col0;
#pragma unroll
                    for (int bj = 0; bj < 2; ++bj) { const f32x4 v0 = acc[ai][bj][m][0], v1 = acc[ai][bj][m][1];
                        u32x4 w; w.x = cvt_pk_bf16(v0[0], v0[1]); w.y = cvt_pk_bf16(v0[2], v0[3]); w.z = cvt_pk_bf16(v1[0], v1[1]); w.w = cvt_pk_bf16(v1[2], v1[3]);
                        *(u32x4*)(rowp + bj * HALF) = w; } }
        } else if (wc == 0) {
#pragma unroll
            for (int ai = 0; ai < 2; ++ai)
#pragma unroll
                for (int m = 0; m < 4; ++m) { float* rp = DT + (size_t)(row0 + ai * HALF + m * 16) * 32 + 8 * fq;
                    *(f32x4*)rp = acc[ai][0][m][0]; *(f32x4*)(rp + 4) = acc[ai][0][m][1]; }
        }
    }
};
struct EpiKV {
    static constexpr bool PERM = true, AFTER_DRAIN = false;
    bf16_t* KB; bf16_t* VB; float* LOGF; float* out;
    __device__ __forceinline__ void operator()(const f32x4 (&acc)[2][2][4][2], const Unit& u, int wr, int wc, int fr, int fq) const {
        const int row0 = u.pm * BM + wr * 64 + fr;
        const bool prompt = (u.pm * BM) < TP;
        if (u.pn < 8) {
            const bool isv = u.pn >= 4;
            const int colb = (u.pn & 3) * BM + wc * 32 + 8 * fq;
            bf16_t* bb = isv ? VB : KB;
            float* fb = out + (prompt ? (isv ? O_PV : O_PK) : (isv ? O_SV : O_SK));
#pragma unroll
            for (int ai = 0; ai < 2; ++ai)
#pragma unroll
                for (int m = 0; m < 4; ++m) { const int row = row0 + ai * HALF + m * 16; const int orow = prompt ? row : row - TP;
#pragma unroll
                    for (int bj = 0; bj < 2; ++bj) { const f32x4 v0 = acc[ai][bj][m][0], v1 = acc[ai][bj][m][1]; const int col = colb + bj * HALF;
                        u32x4 w; w.x = cvt_pk_bf16(v0[0], v0[1]); w.y = cvt_pk_bf16(v0[2], v0[3]); w.z = cvt_pk_bf16(v1[0], v1[1]); w.w = cvt_pk_bf16(v1[2], v1[3]);
                        *(u32x4*)(bb + (size_t)row * 1024 + col) = w;
                        float* fp = fb + (size_t)orow * 1024 + col; *(f32x4*)fp = v0; *(f32x4*)(fp + 4) = v1; } }
        } else if (wc == 0 && fq < 2) {
#pragma unroll
            for (int ai = 0; ai < 2; ++ai)
#pragma unroll
                for (int m = 0; m < 4; ++m) { const int row = row0 + ai * HALF + m * 16;
                    *(f32x4*)(LOGF + (size_t)row * 16 + 8 * fq) = acc[ai][0][m][0]; *(f32x4*)(LOGF + (size_t)row * 16 + 8 * fq + 4) = acc[ai][0][m][1]; }
        }
    }
};
}

DI void p0_transpose_item(const float* W, int K, int ld, int Nvalid, int Npad, bf16* WT, LAS float* scr, int item, int lane) {
    const int nblk = Npad / 32, kb = item / nblk, nb = item % nblk, k0 = 64 * kb, n0 = 32 * nb;
    const int nn = n0 + (lane & 31);
#pragma unroll 8
    for (int i = 0; i < 32; ++i) { const int kk = 2 * i + (lane >> 5); scr[kk * 33 + (lane & 31)] = nn < Nvalid ? W[(size_t)(k0 + kk) * ld + nn] : 0.f; }
    LDS_WAIT(); asm volatile("" ::: "memory");
    const int c = lane & 7;
#pragma unroll
    for (int j = 0; j < 4; ++j) { const int n = (lane >> 3) + 8 * j; const LAS float* s = scr + (8 * c) * 33 + n;
        v4u o; o.x = pk2(s[0 * 33], s[1 * 33]); o.y = pk2(s[2 * 33], s[3 * 33]); o.z = pk2(s[4 * 33], s[5 * 33]); o.w = pk2(s[6 * 33], s[7 * 33]);
        *(GAS v4u*)(WT + (size_t)(n0 + n) * K + k0 + 8 * c) = o; }
    LDS_WAIT(); asm volatile("" ::: "memory");
}

struct TrJob { const float* W; int K, ld, Nvalid, Npad; bf16* WT; };

DI void ph_prologue(const Ctx& c, CArgs a) {
    LAS float* scr = (LAS float*)(c.lds + RING_OFF + c.wave * 16384);
    const int gw = c.vcu * NWAVES + c.wave, NGW = c.G * NWAVES;
    bf16* win = (bf16*)(a->ws + WS_WIN); bf16* wout = (bf16*)(a->ws + WS_WOUT); bf16* wkv = (bf16*)(a->ws + WS_WKV);
    bf16* wqg = (bf16*)(a->ws + WS_WQG); bf16* wo = (bf16*)(a->ws + WS_WO); bf16* wpq = (bf16*)(a->ws + WS_WPQ);
#define TRJOB(Wp, K_, ld_, Nv_, Np_, WTp) do { const int nit = ((K_) / 64) * ((Np_) / 32); for (int it = gw; it < nit; it += NGW) p0_transpose_item((Wp), (K_), (ld_), (Nv_), (Np_), (WTp), scr, it, c.lane); } while (0)
    for (int l = 0; l < 2; ++l) {
        TRJOB(a->in[7] + (size_t)l * 1024 * IN_DIM, 1024, IN_DIM, IN_DIM, IN_PAD, win + (size_t)l * IN_PAD * 1024);
        TRJOB(a->in[14] + (size_t)l * 2048 * 1024, 2048, 1024, 1024, 1024, wout + (size_t)l * 1024 * 2048);
        TRJOB(a->in[17] + (size_t)l * 1024 * 2048, 1024, 2048, 2048, 2048, wqg + (size_t)l * 2048 * 1024);
        TRJOB(a->in[18] + (size_t)l * 1024 * 1024, 1024, 1024, 1024, 1024, wo + (size_t)l * 1024 * 1024);
    }
    TRJOB(a->in[15], 1024, KVN, KVN, KVPAD, wkv);
    for (int l = 0; l < 4; ++l) TRJOB(a->in[19] + (size_t)l * 1024 * 2048, 1024, 2048, 2048, 2048, wpq + (size_t)l * 2048 * 1024);
#undef TRJOB
    { unsigned* skt = (unsigned*)(a->ws + WS_SKT); const float* sk = a->in[20];
      const int gt = (c.vcu * NWAVES + c.wave) * 64 + c.lane, NT = c.G * NWAVES * 64;
      for (int i = gt; i < 4 * 2 * 128 * 64; i += NT) { const int pair = i & 63, d = (i >> 6) & 127, lk = i >> 13;
          const float a = sk[((size_t)lk * 128 + 2 * pair) * 128 + d], b = sk[((size_t)lk * 128 + 2 * pair + 1) * 128 + d];
          skt[i] = pk2(a, b); } }
    { bf16* xb = (bf16*)(a->ws + WS_XB);
      for (int m = gw; m < T; m += NGW) {
          const float* src = m < TP ? a->in[0] + (size_t)m * DM : a->in[1] + (size_t)(m - TP) * DM;
          const GAS f32x4* xr = (const GAS f32x4*)src + c.lane; GAS f32x4* xo = (GAS f32x4*)(a->out + O_Y + (size_t)m * DM) + c.lane;
          GAS unsigned long long* o8 = (GAS unsigned long long*)(xb + (size_t)m * DM) + c.lane;
#pragma unroll
          for (int j = 0; j < 4; ++j) { const f32x4 v = xr[64 * j]; xo[64 * j] = v; o8[64 * j] = (unsigned long long)pk2(v.x, v.y) | ((unsigned long long)pk2(v.z, v.w) << 32); } } }
}

DI void ph_conv(const Ctx& c, CArgs a, int layer) {
    const bf16* ZX = (const bf16*)(a->ws + WS_R1); bf16* XC = (bf16*)(a->ws + WS_XC);
    const float* cw = a->in[8] + (size_t)layer * 4 * CONVD; const float* cb = a->in[9] + (size_t)layer * CONVD; const float* cst = a->in[3] + (size_t)layer * SBT * 3 * CONVD;
    const int gt = (c.vcu * NWAVES + c.wave) * 64 + c.lane, NT = c.G * NWAVES * 64;
    for (int idx = gt; idx < T * 384; idx += NT) {
        const int t = idx / 384, ch = (idx % 384) * 8;
        int s0, l, b; bool sample;
        if (t < TP) { s0 = t & ~(PL - 1); l = t & (PL - 1); b = 0; sample = false; } else { const int ts = t - TP; b = ts >> 6; l = ts & 63; s0 = TP + b * SL; sample = true; }
        float a[8];
        { const f32x4 b0 = *(const f32x4*)(cb + ch), b1 = *(const f32x4*)(cb + ch + 4); a[0] = b0.x; a[1] = b0.y; a[2] = b0.z; a[3] = b0.w; a[4] = b1.x; a[5] = b1.y; a[6] = b1.z; a[7] = b1.w; }
#pragma unroll
        for (int k = 0; k < 4; ++k) {
            const int j = l - 3 + k; float uv[8];
            if (j >= 0) { const v4u w = *(const v4u*)(ZX + (size_t)(s0 + j) * ZXLD + 2048 + ch);
                uv[0] = bflo(w.x); uv[1] = bfhi(w.x); uv[2] = bflo(w.y); uv[3] = bfhi(w.y); uv[4] = bflo(w.z); uv[5] = bfhi(w.z); uv[6] = bflo(w.w); uv[7] = bfhi(w.w); }
            else if (sample) { const float* sp = cst + ((size_t)b * 3 + (j + 3)) * CONVD + ch; const f32x4 s0v = *(const f32x4*)sp, s1v = *(const f32x4*)(sp + 4);
                uv[0] = s0v.x; uv[1] = s0v.y; uv[2] = s0v.z; uv[3] = s0v.w; uv[4] = s1v.x; uv[5] = s1v.y; uv[6] = s1v.z; uv[7] = s1v.w; }
            else {
#pragma unroll
                for (int i = 0; i < 8; ++i) uv[i] = 0.f; }
            const f32x4 w0 = *(const f32x4*)(cw + (size_t)k * CONVD + ch), w1 = *(const f32x4*)(cw + (size_t)k * CONVD + ch + 4);
            a[0] += w0.x * uv[0]; a[1] += w0.y * uv[1]; a[2] += w0.z * uv[2]; a[3] += w0.w * uv[3]; a[4] += w1.x * uv[4]; a[5] += w1.y * uv[5]; a[6] += w1.z * uv[6]; a[7] += w1.w * uv[7];
        }
#pragma unroll
        for (int i = 0; i < 8; ++i) a[i] = silu_f(a[i]);
        v4u o; o.x = pk2(a[0], a[1]); o.y = pk2(a[2], a[3]); o.z = pk2(a[4], a[5]); o.w = pk2(a[6], a[7]);
        *(v4u*)(XC + (size_t)t * CONVD + ch) = o;
    }
    for (int idx = gt; idx < (PB + SBT) * 3 * CONVD; idx += NT) {
        const int ch = idx % CONVD, r = (idx / CONVD) % 3, sq = idx / (3 * CONVD);
        if (sq < PB) { const int row = sq * PL + PL - 3 + r; a->out[O_PCONV + (((size_t)layer * PB + sq) * 3 + r) * CONVD + ch] = bf2f(ZX[(size_t)row * ZXLD + 2048 + ch]); }
        else { const int b = sq - PB; const int row = TP + b * SL + SL - 3 + r; a->out[O_SCONV + (((size_t)layer * SBT + b) * 3 + r) * CONVD + ch] = bf2f(ZX[(size_t)row * ZXLD + 2048 + ch]); }
    }
}

DI void ph_scan(const Ctx& c, CArgs a, int layer) {
    const bf16* XC = (const bf16*)(a->ws + WS_XC); const float* DT = (const float*)(a->ws + WS_DT); bf16* Y = (bf16*)(a->ws + WS_Y);
    LAS float* Bs = (LAS float*)(c.lds + RING_OFF); LAS float* Cs = Bs + 8192; LAS float* xs = Cs + 8192; LAS float* ys = xs + 4096; LAS float* dts = ys + 4096; LAS float* das = dts + 64;
    const int tid = c.tid, p = tid >> 3, nc = tid & 7;
    for (int ui = c.bx; ui < PB * NH + SBT * NH; ui += c.G) {
        const bool sample = ui >= PB * NH; int b, head, row0, ntile;
        if (!sample) { b = ui / NH; head = ui % NH; row0 = b * PL; ntile = PL / 64; } else { const int us = ui - PB * NH; b = us / NH; head = us % NH; row0 = TP + b * SL; ntile = 1; }
        const int g = head >> 3;
        const float Ah = -expf(a->in[11][layer * NH + head]), dtb = a->in[10][layer * NH + head], Dh = a->in[12][layer * NH + head];
        float h[16];
        if (sample) { const float* sp = a->in[2] + (((size_t)layer * SBT + b) * NH + head) * 8192 + p * 128 + nc * 16;
#pragma unroll
            for (int j4 = 0; j4 < 4; ++j4) { const f32x4 v = *(const f32x4*)(sp + 4 * j4); h[4 * j4] = v.x; h[4 * j4 + 1] = v.y; h[4 * j4 + 2] = v.z; h[4 * j4 + 3] = v.w; } }
        else {
#pragma unroll
            for (int j = 0; j < 16; ++j) h[j] = 0.f; }
        for (int tile = 0; tile < ntile; ++tile) {
            const int t0 = row0 + tile * 64;
            { const int r = tid >> 3, cs = (tid & 7) * 16; const bf16* rp = XC + (size_t)(t0 + r) * CONVD;
#pragma unroll
              for (int q = 0; q < 2; ++q) { const v4u wb = *(const v4u*)(rp + 2048 + g * 128 + cs + 8 * q), wc2 = *(const v4u*)(rp + 2560 + g * 128 + cs + 8 * q);
                  LAS float* bd = Bs + r * 128 + cs + 8 * q; LAS float* cd = Cs + r * 128 + cs + 8 * q;
                  *(LAS f32x4*)bd = (f32x4){bflo(wb.x), bfhi(wb.x), bflo(wb.y), bfhi(wb.y)}; *(LAS f32x4*)(bd + 4) = (f32x4){bflo(wb.z), bfhi(wb.z), bflo(wb.w), bfhi(wb.w)};
                  *(LAS f32x4*)cd = (f32x4){bflo(wc2.x), bfhi(wc2.x), bflo(wc2.y), bfhi(wc2.y)}; *(LAS f32x4*)(cd + 4) = (f32x4){bflo(wc2.z), bfhi(wc2.z), bflo(wc2.w), bfhi(wc2.w)}; }
              const int xsg = (tid & 7) * 8; const v4u wx = *(const v4u*)(rp + head * 64 + xsg); LAS float* xd = xs + r * 64 + xsg;
              *(LAS f32x4*)xd = (f32x4){bflo(wx.x), bfhi(wx.x), bflo(wx.y), bfhi(wx.y)}; *(LAS f32x4*)(xd + 4) = (f32x4){bflo(wx.z), bfhi(wx.z), bflo(wx.w), bfhi(wx.w)};
              if (tid < 64) { const float sp = softplus_f(DT[(size_t)(t0 + tid) * 32 + head] + dtb); dts[tid] = sp; das[tid] = expf(sp * Ah); } }
            __syncthreads();
            for (int i = 0; i < 64; ++i) {
                const float xraw = xs[i * 64 + p], dtv = dts[i], dec = das[i], xv = xraw * dtv;
                float part = 0.f;
#pragma unroll
                for (int j4 = 0; j4 < 4; ++j4) { const f32x4 bv = *(const LAS f32x4*)(Bs + i * 128 + nc * 16 + 4 * j4), cv = *(const LAS f32x4*)(Cs + i * 128 + nc * 16 + 4 * j4);
                    h[4 * j4] = dec * h[4 * j4] + xv * bv.x; h[4 * j4 + 1] = dec * h[4 * j4 + 1] + xv * bv.y; h[4 * j4 + 2] = dec * h[4 * j4 + 2] + xv * bv.z; h[4 * j4 + 3] = dec * h[4 * j4 + 3] + xv * bv.w;
                    part += cv.x * h[4 * j4] + cv.y * h[4 * j4 + 1] + cv.z * h[4 * j4 + 2] + cv.w * h[4 * j4 + 3]; }
                part += __shfl_xor(part, 1); part += __shfl_xor(part, 2); part += __shfl_xor(part, 4);
                if (nc == 0) ys[i * 64 + p] = part + Dh * xraw;
            }
            __syncthreads();
            { const int r = tid >> 3, cs = (tid & 7) * 8; const LAS float* yp = ys + r * 64 + cs; const f32x4 y0 = *(const LAS f32x4*)yp, y1 = *(const LAS f32x4*)(yp + 4);
              v4u o; o.x = pk2(y0.x, y0.y); o.y = pk2(y0.z, y0.w); o.z = pk2(y1.x, y1.y); o.w = pk2(y1.z, y1.w);
              *(v4u*)(Y + (size_t)(t0 + r) * DIN + head * 64 + cs) = o; }
        }
        { float* op = a->out + (sample ? O_SSSM + (((size_t)layer * SBT + b) * NH + head) * 8192 : O_PSSM + (((size_t)layer * PB + b) * NH + head) * 8192) + p * 128 + nc * 16;
#pragma unroll
          for (int j4 = 0; j4 < 4; ++j4) *(f32x4*)(op + 4 * j4) = (f32x4){h[4 * j4], h[4 * j4 + 1], h[4 * j4 + 2], h[4 * j4 + 3]}; }
        __syncthreads();
    }
}

DI void ph_gnorm(const Ctx& c, CArgs a, int layer) {
    const bf16* ZX = (const bf16*)(a->ws + WS_R1); bf16* Y = (bf16*)(a->ws + WS_Y); const float* nw = a->in[13] + (size_t)layer * DIN;
    const int gw = c.vcu * NWAVES + c.wave, NGW = c.G * NWAVES, ch0 = c.lane * 32;
    for (int m = gw; m < T; m += NGW) {
        float hv[32]; float ss = 0.f;
#pragma unroll
        for (int q = 0; q < 4; ++q) { const v4u wy = *(const v4u*)(Y + (size_t)m * DIN + ch0 + 8 * q), wz = *(const v4u*)(ZX + (size_t)m * ZXLD + ch0 + 8 * q);
            const unsigned yy[4] = {wy.x, wy.y, wy.z, wy.w}, zz[4] = {wz.x, wz.y, wz.z, wz.w};
#pragma unroll
            for (int i = 0; i < 4; ++i) { const float a = bflo(yy[i]) * silu_f(bflo(zz[i])), b = bfhi(yy[i]) * silu_f(bfhi(zz[i])); hv[8 * q + 2 * i] = a; hv[8 * q + 2 * i + 1] = b; ss += a * a + b * b; } }
        ss += __shfl_xor(ss, 1); ss += __shfl_xor(ss, 2); ss += __shfl_xor(ss, 4); ss += __shfl_xor(ss, 8);
        const float rstd = 1.f / sqrtf(ss * (1.f / 512.f) + RMS_EPS);
#pragma unroll
        for (int q = 0; q < 4; ++q) { const f32x4 w0 = *(const f32x4*)(nw + ch0 + 8 * q), w1 = *(const f32x4*)(nw + ch0 + 8 * q + 4);
            v4u o; o.x = pk2(hv[8 * q] * rstd * w0.x, hv[8 * q + 1] * rstd * w0.y); o.y = pk2(hv[8 * q + 2] * rstd * w0.z, hv[8 * q + 3] * rstd * w0.w);
            o.z = pk2(hv[8 * q + 4] * rstd * w1.x, hv[8 * q + 5] * rstd * w1.y); o.w = pk2(hv[8 * q + 6] * rstd * w1.z, hv[8 * q + 7] * rstd * w1.w);
            *(v4u*)(Y + (size_t)m * DIN + ch0 + 8 * q) = o; }
    }
}

DI void ph_ln(const Ctx& c, CArgs a, int layer, int which) {
    const float* R = (const float*)(a->ws + WS_MIX); bf16* xb = (bf16*)(a->ws + WS_XB);
    const float* g = a->in[23] + ((size_t)layer * 2 + which) * DM; const float* be = a->in[24] + ((size_t)layer * 2 + which) * DM;
    const int gw = c.vcu * NWAVES + c.wave, NGW = c.G * NWAVES;
    for (int m = gw; m < T; m += NGW) {
        GAS f32x4* xr = (GAS f32x4*)(a->out + O_Y + (size_t)m * DM) + c.lane; const GAS f32x4* rr = (const GAS f32x4*)(R + (size_t)m * DM) + c.lane;
        f32x4 v[4]; float s = 0.f;
#pragma unroll
        for (int j = 0; j < 4; ++j) { v[j] = xr[64 * j] * DN_ALPHA + rr[64 * j]; s += (v[j].x + v[j].y) + (v[j].z + v[j].w); }
        const float mean = wave_sum(s) * (1.f / DM); float s2 = 0.f;
#pragma unroll
        for (int j = 0; j < 4; ++j) { v[j] = v[j] - mean; s2 += (v[j].x * v[j].x + v[j].y * v[j].y) + (v[j].z * v[j].z + v[j].w * v[j].w); }
        const float rstd = 1.f / sqrtf(wave_sum(s2) * (1.f / DM) + LN_EPS);
        GAS unsigned long long* o8 = (GAS unsigned long long*)(xb + (size_t)m * DM) + c.lane;
#pragma unroll
        for (int j = 0; j < 4; ++j) { const f32x4 gg = *((const f32x4*)g + 64 * j + c.lane), bb = *((const f32x4*)be + 64 * j + c.lane);
            const f32x4 o = v[j] * rstd * gg + bb; xr[64 * j] = o; o8[64 * j] = (unsigned long long)pk2(o.x, o.y) | ((unsigned long long)pk2(o.z, o.w) << 32); }
    }
}

DI float topk_round(float& a, float& b, int lane, int r, float& mine) {
    const float M = wave_max(fmaxf(a, b));
    const bool ea = (a == M), eb = (!ea) && (b == M);
    a = ea ? -INFINITY : a; b = eb ? -INFINITY : b;
    if (lane == r) mine = M;
    return M;
}
DI void ph_topk(const Ctx& c, CArgs a, int layer) {
    const bf16* PQ = (const bf16*)(a->ws + WS_PQ); int* EIDX = (int*)(a->ws + WS_EIDX); float* GATE = (float*)(a->ws + WS_GATE);
    LAS unsigned* skt = (LAS unsigned*)(c.lds + RING_OFF); LAS float* qs = (LAS float*)(c.lds + RING_OFF + 65536) + c.wave * 256;
    { const unsigned* src = (const unsigned*)(a->ws + WS_SKT) + (size_t)layer * 16384; for (int i = c.tid; i < 16384; i += NWAVES * 64) skt[i] = src[i]; }
    __syncthreads();
    const int gw = c.vcu * NWAVES + c.wave, NGW = c.G * NWAVES, lane = c.lane;
    for (int task = gw; task < T * 8; task += NGW) {
        const int t = task >> 3, hd = task & 7;
        { const unsigned long long w = *((const unsigned long long*)(PQ + (size_t)t * 2048 + hd * 256) + lane);
          *(LAS f32x4*)(qs + 4 * lane) = (f32x4){bflo((unsigned)w), bfhi((unsigned)w), bflo((unsigned)(w >> 32)), bfhi((unsigned)(w >> 32))}; }
        float tk0 = 0.f, tk1 = 0.f;
#define TOPK_HALF(k, TK) do { float a0 = 0.f, a1 = 0.f; \
            _Pragma("unroll 4") for (int d4 = 0; d4 < 32; ++d4) { const f32x4 q4 = *(const LAS f32x4*)(qs + (k) * 128 + 4 * d4); \
                _Pragma("unroll") for (int dd = 0; dd < 4; ++dd) { const unsigned w = skt[((k) * 128 + 4 * d4 + dd) * 64 + lane]; a0 += q4[dd] * bflo(w); a1 += q4[dd] * bfhi(w); } } \
            float pa = __uint_as_float((__float_as_uint(a0) & ~0x7fu) | (unsigned)(2 * lane)), pb = __uint_as_float((__float_as_uint(a1) & ~0x7fu) | (unsigned)(2 * lane + 1)); \
            for (int r = 0; r < 16; ++r) topk_round(pa, pb, lane, r, TK); } while (0)
        TOPK_HALF(0, tk0); TOPK_HALF(1, tk1);
#undef TOPK_HALF
        float cd[4];
        { const float v1 = __uint_as_float(__float_as_uint(__shfl(tk0, lane >> 2)) & ~0x7fu);
#pragma unroll
          for (int m = 0; m < 4; ++m) { const float v2 = __uint_as_float(__float_as_uint(__shfl(tk1, (lane & 3) * 4 + m)) & ~0x7fu);
              cd[m] = __uint_as_float((__float_as_uint(v1 + v2) & ~0xffu) | (unsigned)(4 * lane + m)); } }
        float best = 0.f;
        for (int r = 0; r < 16; ++r) {
            const float M = wave_max(fmaxf(fmaxf(cd[0], cd[1]), fmaxf(cd[2], cd[3])));
            { const bool e0 = cd[0] == M, e1 = !e0 && cd[1] == M, e2 = !e0 && !e1 && cd[2] == M, e3 = !e0 && !e1 && !e2 && cd[3] == M;
              cd[0] = e0 ? -INFINITY : cd[0]; cd[1] = e1 ? -INFINITY : cd[1]; cd[2] = e2 ? -INFINITY : cd[2]; cd[3] = e3 ? -INFINITY : cd[3]; }
            if (lane == r) best = M;
        }
        const unsigned bb = __float_as_uint(best); const int cc = (int)(bb & 0xffu) & 255; const float bv = __uint_as_float(bb & ~0xffu);
        const int e1 = (int)(__float_as_uint(__shfl(tk0, (cc >> 4) & 15)) & 0x7fu), e2 = (int)(__float_as_uint(__shfl(tk1, cc & 15)) & 0x7fu);
        const float mx = __shfl(bv, 0); float ex = lane < 16 ? __expf(bv - mx) : 0.f;
        const float sm = wave_sum(ex);
        if (lane < 16) { EIDX[(size_t)t * 128 + hd * 16 + lane] = e1 * 128 + e2; GATE[(size_t)t * 128 + hd * 16 + lane] = ex / sm; }
    }
    __syncthreads();
}

DI void ph_gather(const Ctx& c, CArgs a, int layer) {
    const int* EIDX = (const int*)(a->ws + WS_EIDX); const float* GATE = (const float*)(a->ws + WS_GATE); float* PE = (float*)(a->ws + WS_MIX);
    const float* U = a->in[21] + (size_t)layer * NEXP * DM; const float* V = a->in[22] + (size_t)layer * NEXP * DM;
    const int gw = c.vcu * NWAVES + c.wave, NGW = c.G * NWAVES, lane = c.lane;
    for (int t = gw; t < T; t += NGW) {
        const GAS f32x4* xr = (const GAS f32x4*)(a->out + O_Y + (size_t)t * DM) + lane;
        f32x4 x[4], acc[4];
#pragma unroll
        for (int j = 0; j < 4; ++j) { x[j] = xr[64 * j]; acc[j] = (f32x4){0.f, 0.f, 0.f, 0.f}; }
        const int e_lo = EIDX[(size_t)t * 128 + lane], e_hi = EIDX[(size_t)t * 128 + 64 + lane];
        const float g_lo = GATE[(size_t)t * 128 + lane], g_hi = GATE[(size_t)t * 128 + 64 + lane];
        for (int kb = 0; kb < 32; ++kb) {
            int e[4]; float gk[4], dot[4];
#pragma unroll
            for (int q = 0; q < 4; ++q) { const int k = kb * 4 + q; const int ev = kb < 16 ? __shfl(e_lo, k & 63) : __shfl(e_hi, k & 63); const float gv = kb < 16 ? __shfl(g_lo, k & 63) : __shfl(g_hi, k & 63);
                e[q] = __builtin_amdgcn_readfirstlane(ev) & (NEXP - 1); gk[q] = gv; }
#pragma unroll
            for (int q = 0; q < 4; ++q) { const GAS f32x4* ur = (const GAS f32x4*)(U + (size_t)e[q] * DM) + lane; float d = 0.f;
#pragma unroll
                for (int j = 0; j < 4; ++j) { const f32x4 u4 = ur[64 * j]; d += (u4.x * x[j].x + u4.y * x[j].y) + (u4.z * x[j].z + u4.w * x[j].w); }
                dot[q] = d; }
#pragma unroll
            for (int q = 0; q < 4; ++q) dot[q] = gelu_erf(wave_sum(dot[q])) * gk[q];
#pragma unroll
            for (int q = 0; q < 4; ++q) { const GAS f32x4* vr = (const GAS f32x4*)(V + (size_t)e[q] * DM) + lane;
#pragma unroll
                for (int j = 0; j < 4; ++j) acc[j] += vr[64 * j] * dot[q]; }
        }
        GAS f32x4* po = (GAS f32x4*)(PE + (size_t)t * DM) + lane;
#pragma unroll
        for (int j = 0; j < 4; ++j) po[64 * j] = acc[j];
    }
}

DI void ph_cumsum(const Ctx& c, CArgs a) {
    const float* LOGF = (const float*)(a->ws + WS_LOGF); float* CKP = (float*)(a->ws + WS_CKP); float* CKS = (float*)(a->ws + WS_CKS);
    const int gw = c.vcu * NWAVES + c.wave, NGW = c.G * NWAVES, lane = c.lane;
    for (int task = gw; task < PB * AH + SBT * AH; task += NGW) {
        if (task < PB * AH) {
            const int b = task >> 4, h = task & 15; const float bias = a->in[16][h]; float s = 0.f;
            for (int i = 0; i < 32; ++i) { const size_t r = (size_t)b * PL + lane * 32 + i; const float lf = logsigmoid_f(LOGF[r * 16 + h] + bias); a->out[O_PLOGF + r * 16 + h] = lf; s += lf; }
            float inc = s;
#pragma unroll
            for (int o = 1; o < 64; o <<= 1) { const float v = __shfl_up(inc, o); if (lane >= o) inc += v; }
            float run = inc - s;
            for (int i = 0; i < 32; ++i) { const size_t r = (size_t)b * PL + lane * 32 + i; run += a->out[O_PLOGF + r * 16 + h]; CKP[r * 16 + h] = run; }
        } else {
            const int ts = task - PB * AH, b = ts >> 4, h = ts & 15; const float bias = a->in[16][h]; float s = 0.f;
            for (int i = 0; i < 17; ++i) { const int pos = lane * 17 + i; float lf;
                if (pos < PAST) lf = a->in[6][((size_t)b * PAST + pos) * 16 + h];
                else { const size_t r = (size_t)b * SL + (pos - PAST); lf = logsigmoid_f(LOGF[((size_t)TP + r) * 16 + h] + bias); a->out[O_SLOGF + r * 16 + h] = lf; }
                s += lf; }
            float inc = s;
#pragma unroll
            for (int o = 1; o < 64; o <<= 1) { const float v = __shfl_up(inc, o); if (lane >= o) inc += v; }
            float run = inc - s;
            for (int i = 0; i < 17; ++i) { const int pos = lane * 17 + i; float lf;
                if (pos < PAST) lf = a->in[6][((size_t)b * PAST + pos) * 16 + h]; else lf = a->out[O_SLOGF + ((size_t)b * SL + (pos - PAST)) * 16 + h];
                run += lf; CKS[((size_t)b * SKV + pos) * 16 + h] = run; }
        }
    }
}

DI void ph_attn(const Ctx& c, CArgs a) {
    const bf16* QB = (const bf16*)(a->ws + WS_QB); const bf16* GB = (const bf16*)(a->ws + WS_GB); bf16* OG = (bf16*)(a->ws + WS_OG);
    const bf16* KB = (const bf16*)(a->ws + WS_KB); const bf16* VB = (const bf16*)(a->ws + WS_VB);
    const float* CKP = (const float*)(a->ws + WS_CKP); const float* CKS = (const float*)(a->ws + WS_CKS);
    const float* cache_k = a->in[4]; const float* cache_v = a->in[5];
    LAS float* Ks = (LAS float*)(c.lds + RING_OFF + c.wave * 8448); LAS float* Vs = Ks + 1024; LAS float* cks = Vs + 1024;
    const int gw = c.vcu * NWAVES + c.wave, NGW = c.G * NWAVES, lane = c.lane, ql = lane >> 1, dh = (lane & 1) * 32;
    const int NPT = PB * AH * (PL / 32), NTASK = NPT + SBT * AH * 2;
    for (int task = gw; task < NTASK; task += NGW) {
        bool sample; int b, h, qrow, qpos, kend; const float* ck;
        if (task < NPT) { const int qblk = (PL / 32 - 1) - (task >> 8), bh = task & 255; b = bh >> 4; h = bh & 15; sample = false;
            qpos = qblk * 32 + ql; qrow = b * PL + qpos; kend = qblk * 32 + 32; ck = CKP + (size_t)b * PL * 16 + h; }
        else { const int s = task - NPT, half = s & 1, bh = s >> 1; b = bh >> 4; h = bh & 15; sample = true; qpos = PAST + half * 32 + ql; qrow = TP + b * SL + half * 32 + ql; kend = PAST + half * 32 + 32; ck = CKS + (size_t)b * SKV * 16 + h; }
        float q[32], o[32];
#pragma unroll
        for (int d8 = 0; d8 < 4; ++d8) { const v4u w = *(const v4u*)(QB + (size_t)qrow * DM + h * 64 + dh + 8 * d8);
            q[8 * d8] = bflo(w.x) * ATT_SCALE; q[8 * d8 + 1] = bfhi(w.x) * ATT_SCALE; q[8 * d8 + 2] = bflo(w.y) * ATT_SCALE; q[8 * d8 + 3] = bfhi(w.y) * ATT_SCALE;
            q[8 * d8 + 4] = bflo(w.z) * ATT_SCALE; q[8 * d8 + 5] = bfhi(w.z) * ATT_SCALE; q[8 * d8 + 6] = bflo(w.w) * ATT_SCALE; q[8 * d8 + 7] = bfhi(w.w) * ATT_SCALE; }
#pragma unroll
        for (int d = 0; d < 32; ++d) o[d] = 0.f;
        const float cq = ck[(size_t)qpos * 16];
        float mrun = -1e30f, lrun = 0.f;
        for (int k0 = 0; k0 < kend; k0 += 8) {
            { const int key = lane >> 3, d0 = (lane & 7) * 8, kp = k0 + key;
              if (sample && kp < PAST) {
                  const float* kr = cache_k + (((size_t)b * PAST + kp) * AH + h) * 64 + d0; const float* vr = cache_v + (((size_t)b * PAST + kp) * AH + h) * 64 + d0;
#pragma unroll
                  for (int i = 0; i < 2; ++i) { *(LAS f32x4*)(Ks + key * 64 + d0 + 4 * i) = *(const f32x4*)(kr + 4 * i); *(LAS f32x4*)(Vs + key * 64 + d0 + 4 * i) = *(const f32x4*)(vr + 4 * i); }
              } else {
                  const size_t row = sample ? (size_t)TP + b * SL + (kp - PAST) : (size_t)b * PL + kp;
                  const v4u wk = *(const v4u*)(KB + row * DM + h * 64 + d0), wv = *(const v4u*)(VB + row * DM + h * 64 + d0);
                  *(LAS f32x4*)(Ks + key * 64 + d0) = (f32x4){bflo(wk.x), bfhi(wk.x), bflo(wk.y), bfhi(wk.y)}; *(LAS f32x4*)(Ks + key * 64 + d0 + 4) = (f32x4){bflo(wk.z), bfhi(wk.z), bflo(wk.w), bfhi(wk.w)};
                  *(LAS f32x4*)(Vs + key * 64 + d0) = (f32x4){bflo(wv.x), bfhi(wv.x), bflo(wv.y), bfhi(wv.y)}; *(LAS f32x4*)(Vs + key * 64 + d0 + 4) = (f32x4){bflo(wv.z), bfhi(wv.z), bflo(wv.w), bfhi(wv.w)};
              }
              if (lane < 8) cks[lane] = ck[(size_t)(k0 + lane) * 16]; }
            asm volatile("s_waitcnt lgkmcnt(0)" ::: "memory");
            float s[8]; float tmax = -1e30f;
#pragma unroll
            for (int j = 0; j < 8; ++j) { float acc = 0.f;
#pragma unroll
                for (int d4 = 0; d4 < 8; ++d4) { const f32x4 k4 = *(const LAS f32x4*)(Ks + j * 64 + dh + 4 * d4); acc += (q[4 * d4] * k4.x + q[4 * d4 + 1] * k4.y) + (q[4 * d4 + 2] * k4.z + q[4 * d4 + 3] * k4.w); }
                acc += __shfl_xor(acc, 1);
                acc += cq - cks[j]; if (k0 + j > qpos) acc = -1e30f; s[j] = acc; tmax = fmaxf(tmax, acc); }
            const float mnew = fmaxf(mrun, tmax), f = __expf(mrun - mnew); mrun = mnew; lrun *= f;
#pragma unroll
            for (int d = 0; d < 32; ++d) o[d] *= f;
#pragma unroll
            for (int j = 0; j < 8; ++j) { const float p = __expf(s[j] - mnew); lrun += p;
#pragma unroll
                for (int d4 = 0; d4 < 8; ++d4) { const f32x4 v4 = *(const LAS f32x4*)(Vs + j * 64 + dh + 4 * d4); o[4 * d4] += p * v4.x; o[4 * d4 + 1] += p * v4.y; o[4 * d4 + 2] += p * v4.z; o[4 * d4 + 3] += p * v4.w; } }
            asm volatile("s_waitcnt lgkmcnt(0)" ::: "memory");
        }
        const float inv = 1.f / lrun;
#pragma unroll
        for (int d8 = 0; d8 < 4; ++d8) { const v4u wg = *(const v4u*)(GB + (size_t)qrow * DM + h * 64 + dh + 8 * d8); const unsigned gg[4] = {wg.x, wg.y, wg.z, wg.w}; unsigned ow[4];
#pragma unroll
            for (int i = 0; i < 4; ++i) ow[i] = pk2(o[8 * d8 + 2 * i] * inv * sigmoid_f(bflo(gg[i])), o[8 * d8 + 2 * i + 1] * inv * sigmoid_f(bfhi(gg[i])));
            *(v4u*)(OG + (size_t)qrow * DM + h * 64 + dh + 8 * d8) = (v4u){ow[0], ow[1], ow[2], ow[3]}; }
    }
}

constexpr int N_PHASES = 39;
__global__ void __launch_bounds__(NWAVES * 64, 2) mk_fwd(Args args_unused) {
    extern __shared__ __attribute__((aligned(16))) unsigned char lds[];
    { const int t0 = threadIdx.x; for (int u = t0; u < (LDS_BYTES - LDSCTL_OFF) / 4; u += NWAVES * 64) ((LAS unsigned*)((LAS unsigned char*)lds + LDSCTL_OFF))[u] = 0u; }
    __syncthreads();
    volatile LAS unsigned* MISC = (volatile LAS unsigned*)((LAS unsigned char*)lds + MISC_OFF);
    int lo, hi; XcdBarrier bar;
    { CArgs a = kargs(); lo = a->ph_lo; hi = a->ph_hi; bar = xcd_barrier_post((unsigned*)(a->ws + WS_CTL) + CW_BAR + (size_t)a->li * XCD_BAR_WORDS, MISC + 8); }
    int pc = 0;
#define PH_BEGIN if (lo <= pc && pc < hi) { CArgs a = kargs(); const Ctx c = mkctx((LAS unsigned char*)lds);
#define PH_END   if (pc + 1 < hi) xcd_barrier(bar); } ++pc;
#define RING (c.lds + RING_OFF)
#define WSP(T_, off) ((T_*)(a->ws + (off)))

    PH_BEGIN ph_prologue(c, a); PH_END

#define PEER_PHASES(layer) \
        PH_BEGIN ph_ln(c, a, layer, 0); PH_END \
        PH_BEGIN { pg8::Gemm g{WSP(const bf16, WS_XB), WSP(const bf16, WS_WPQ) + (size_t)(layer) * 2048 * 1024, T, 2048, 1024}; pg8::StaticOrder S; S.init(T, 2048, c.G, c.bx); \
                   pg8::EpiBf16<0> E{WSP(bf16, WS_PQ), 2048, nullptr, 0, 0, 1.f}; \
                   pg8::gemm_phase<pg8::EpiBf16<0>, pg8::StaticOrder, true, true>(RING, g, S, E); } PH_END \
        PH_BEGIN ph_topk(c, a, layer); PH_END \
        PH_BEGIN ph_gather(c, a, layer); PH_END \
        PH_BEGIN ph_ln(c, a, layer, 1); PH_END
#define LAYER_A(layer) \
            PH_BEGIN { pg8::Gemm g{WSP(const bf16, WS_XB), WSP(const bf16, WS_WIN) + (size_t)(layer) * IN_PAD * 1024, T, IN_PAD, 1024}; pg8::StaticOrder S; S.init(T, IN_PAD, c.G, c.bx); \
                       pg8::EpiInproj E{WSP(bf16, WS_R1), WSP(float, WS_DT)}; \
                       pg8::gemm_phase<pg8::EpiInproj, pg8::StaticOrder, true, true>(RING, g, S, E); } PH_END \
            PH_BEGIN ph_conv(c, a, layer); PH_END \
            PH_BEGIN ph_scan(c, a, layer); PH_END \
            PH_BEGIN ph_gnorm(c, a, layer); PH_END \
            PH_BEGIN { pg8::Gemm g{WSP(const bf16, WS_Y), WSP(const bf16, WS_WOUT) + (size_t)(layer) * 1024 * 2048, T, 1024, 2048}; pg8::StaticOrder S; S.init(T, 1024, c.G, c.bx); \
                       pg8::EpiF32 E{WSP(float, WS_MIX), 1024, nullptr}; \
                       pg8::gemm_phase<pg8::EpiF32, pg8::StaticOrder, true, true>(RING, g, S, E); } PH_END \
            PEER_PHASES(layer)
#define LAYER_B(layer) \
            PH_BEGIN { pg8::Gemm g{WSP(const bf16, WS_XB), WSP(const bf16, WS_WQG) + (size_t)((layer) - 2) * 2048 * 1024, T, 2048, 1024}; pg8::StaticOrder S; S.init(T, 2048, c.G, c.bx); \
                       pg8::EpiBf16<0> E{WSP(bf16, WS_QB), 1024, nullptr, 1024, (size_t)(WS_GB - WS_QB) / 2, 1.f}; \
                       pg8::gemm_phase<pg8::EpiBf16<0>, pg8::StaticOrder, true, true>(RING, g, S, E); } PH_END \
            PH_BEGIN ph_attn(c, a); PH_END \
            PH_BEGIN { pg8::Gemm g{WSP(const bf16, WS_OG), WSP(const bf16, WS_WO) + (size_t)((layer) - 2) * 1024 * 1024, T, 1024, 1024}; pg8::StaticOrder S; S.init(T, 1024, c.G, c.bx); \
                       pg8::EpiF32 E{WSP(float, WS_MIX), 1024, nullptr}; \
                       pg8::gemm_phase<pg8::EpiF32, pg8::StaticOrder, true, true>(RING, g, S, E); } PH_END \
            PEER_PHASES(layer)

    LAYER_A(0)
    LAYER_A(1)
    PH_BEGIN { pg8::Gemm g{WSP(const bf16, WS_XB), WSP(const bf16, WS_WKV), T, KVPAD, 1024}; pg8::StaticOrder S; S.init(T, KVPAD, c.G, c.bx);
               pg8::EpiKV E{WSP(bf16, WS_KB), WSP(bf16, WS_VB), WSP(float, WS_LOGF), a->out};
               pg8::gemm_phase<pg8::EpiKV, pg8::StaticOrder, true, true>(RING, g, S, E); } PH_END
    PH_BEGIN ph_cumsum(c, a); PH_END
    LAYER_B(2)
    LAYER_B(3)
#undef PH_BEGIN
#undef PH_END
}

#ifndef MK_N_LAUNCHES
#define MK_N_LAUNCHES 39
#endif
extern "C" void kernel_launch(void* const* d_in, const int* in_sizes, int n_in, void* d_out, int out_size, void* d_ws, size_t ws_size, hipStream_t stream) {
    static int grid = 0;
    if (grid == 0) {
        if (n_in != 25 || out_size != (int)O_END || ws_size < WS_END) { fprintf(stderr, "kernel_launch: unexpected shapes: n_in %d out %d ws %zu\n", n_in, out_size, ws_size); grid = -1; return; }
        int dev = 0, cus = 0, per_cu = 0;
        if (hipGetDevice(&dev) != hipSuccess || hipDeviceGetAttribute(&cus, hipDeviceAttributeMultiprocessorCount, dev) != hipSuccess) { grid = -1; return; }
        if (hipFuncSetAttribute((const void*)mk_fwd, hipFuncAttributeMaxDynamicSharedMemorySize, LDS_BYTES) != hipSuccess) { fprintf(stderr, "kernel_launch: hipFuncSetAttribute failed\n"); grid = -1; return; }
        if (hipOccupancyMaxActiveBlocksPerMultiprocessor(&per_cu, (const void*)mk_fwd, NWAVES * 64, LDS_BYTES) != hipSuccess || per_cu < 1) { fprintf(stderr, "kernel_launch: occupancy query says %d\n", per_cu); }
        (void)hipGetLastError();
        grid = cus;
    }
    if (grid < 0) return;
    if (hipMemsetAsync((char*)d_ws + WS_CTL, 0, CTL_ZERO_BYTES, stream) != hipSuccess) return;
    Args a{};
    for (int i = 0; i < 25; ++i) a.in[i] = (const float*)d_in[i];
    a.out = (float*)d_out; a.ws = (unsigned char*)d_ws; a.pad = 0;
    constexpr int NL = MK_N_LAUNCHES;
    static_assert(NL >= 1 && NL <= MAX_BAR_REGIONS && NL <= N_PHASES, "launch count");
    for (int li = 0; li < NL; ++li) {
        a.ph_lo = (int)((long)li * N_PHASES / NL); a.ph_hi = (int)((long)(li + 1) * N_PHASES / NL); a.li = li;
        hipLaunchKernelGGL(mk_fwd, dim3(grid), dim3(NWAVES * 64), LDS_BYTES, stream, a);
        const hipError_t le = hipPeekAtLastError();
        if (le != hipSuccess) { fprintf(stderr, "kernel_launch: launch %d failed: %s\n", li, hipGetErrorName(le)); break; }
    }
}
```

```cpp
#include <hip/hip_runtime.h>
#include <cstdio>
#include <cstdint>
namespace pg8 {
#define PG8_LAS __attribute__((address_space(3)))
typedef unsigned short bf16_t;
typedef short bf16x8 __attribute__((ext_vector_type(8)));
typedef float f32x4 __attribute__((ext_vector_type(4)));
typedef unsigned u32x4 __attribute__((ext_vector_type(4)));
constexpr int BM = 256, BK = 64, HALF = 128, HTB = HALF * BK * 2  , STAGE_BYTES = 8 * HTB, NXCD = 8, WGM = 4;

__host__ __device__ __forceinline__ int lds_byte(int r, int c) { const int st = (r >> 4) * 2 + (c >> 5), rr = r & 15, cc = c & 31, ob = rr * 64 + cc * 2; return st * 1024 + (ob ^ (((ob >> 9) & 1) << 5)); }
__host__ __device__ __forceinline__ void stage_rc(int b, int& R, int& C) { const int st = b / 1024, sb = b % 1024, swz = sb ^ (((sb >> 9) & 1) << 5); R = (st >> 1) * 16 + swz / 64; C = (st & 1) * 32 + (swz % 64) / 2; }
__host__ __device__ __forceinline__ int perm32(int rho) { const int n = rho >> 4, i = rho & 15; return 8 * (i >> 2) + 4 * n + (i & 3); }

struct Unit { int pm, pn; };
struct Gemm { const bf16_t* A; const bf16_t* Bt; int M, N, K; };

struct StaticOrder {
    int nM, nN, nwg, G, c;
    __host__ __device__ void init(int M, int N, int G_, int c_) { nM = M / BM; nN = N / BM; nwg = nM * nN; G = G_; c = c_; }
    __host__ __device__ bool next(int i, Unit& u) const {
        const long L = (long)i * G + c; if (L >= nwg) return false;
        int wgid = (int)L; { const int q = nwg / NXCD, r = nwg % NXCD, xcd = wgid % NXCD, off = wgid / NXCD; wgid = (xcd < r ? xcd * (q + 1) : r * (q + 1) + (xcd - r) * q) + off; }
        const int nig = WGM * nN, gid = wgid / nig, fm = gid * WGM, gsz = (nM - fm) < WGM ? (nM - fm) : WGM;
        u.pm = fm + ((wgid % nig) % gsz); u.pn = (wgid % nig) / gsz; return true;
    }
    __device__ __forceinline__ void a_ready(const Unit&) const {}
    __device__ __forceinline__ void done(const Unit&) const {}
};

struct WindowOrder {
    StaticOrder base; int first_i, n_i;
    __device__ __forceinline__ bool next(int j, Unit& u) const { return j < n_i && base.next(first_i + j, u); }
    __device__ __forceinline__ void a_ready(const Unit&) const {}
    __device__ __forceinline__ void done(const Unit&) const {}
};

template <bool SC1> struct HandoffOrderT {
    int G, c; unsigned* cnt; PG8_LAS unsigned* lcnt;
    __device__ void init(int G_, int c_, unsigned* cnt_, PG8_LAS unsigned* lcnt_) { G = G_; c = c_; cnt = cnt_; lcnt = lcnt_; }
    __device__ __forceinline__ bool next(int i, Unit& u) const {
        const long L = (long)i * G + c; if (L >= 544) return false;
        const int l = (int)L;
        if (l < 512) { const int xcd = l & 7, off = l >> 3, idx = off & 15; u.pm = 16 * xcd + 4 * (off >> 4) + (idx & 3); u.pn = idx >> 2; }
        else { const int k = l - 512; u.pm = 128 + (k & 7); u.pn = k >> 3; }
        return true;
    }
    __device__ __forceinline__ void a_ready(const Unit&) const {}
    __device__ __forceinline__ void done(const Unit& u) const {
        asm volatile("s_waitcnt vmcnt(0)" ::: "memory");
        unsigned prev = 0u;
        if ((threadIdx.x & 63) == 0) prev = __hip_atomic_fetch_add(lcnt, 1u, __ATOMIC_RELAXED, __HIP_MEMORY_SCOPE_WORKGROUP);
        prev = (unsigned)__builtin_amdgcn_readfirstlane((int)prev);
        if ((prev & 7u) == 7u && (threadIdx.x & 63) == 0) {
            if constexpr (!SC1) { __builtin_amdgcn_fence(__ATOMIC_RELEASE, "agent");
                asm volatile("s_waitcnt vmcnt(0)" ::: "memory"); }
            (void)__hip_atomic_fetch_add(cnt + u.pm, 1u, __ATOMIC_RELAXED, __HIP_MEMORY_SCOPE_AGENT);
        }
    }
};

__device__ __forceinline__ unsigned cvt_pk_bf16(float lo, float hi) { unsigned r; asm volatile("v_cvt_pk_bf16_f32 %0, %1, %2" : "=v"(r) : "v"(lo), "v"(hi)); return r; }
typedef float f32x2 __attribute__((ext_vector_type(2)));
__device__ __forceinline__ f32x2 gelu_pk(f32x2 v) {
    const f32x2 av = __builtin_elementwise_abs(v), d = av * 0.2316418882f + 1.0f;
    f32x2 t; t.x = __builtin_amdgcn_rcpf(d.x); t.y = __builtin_amdgcn_rcpf(d.y);
    f32x2 q = t * 0.5307027145f + (-0.7265760135f); q = q * t + 0.7107068705f; q = q * t + (-0.142248368f); q = q * t + 0.127414796f; q = q * t;
    const f32x2 s = (v * v) * (-0.72134752044f);
    f32x2 e; e.x = __builtin_amdgcn_exp2f(s.x); e.y = __builtin_amdgcn_exp2f(s.y);
    const f32x2 m = v * (q * e), r = v - m;
    f32x2 o; o.x = v.x < 0.f ? m.x : r.x; o.y = v.y < 0.f ? m.y : r.y; return o;
}

template <int ACT  , bool SC1 = false  > struct EpiBf16 {
    static constexpr bool PERM = true, AFTER_DRAIN = false; static_assert(ACT == 0 || ACT == 1, "EpiBf16: ACT is 0 (none) or 1 (gelu_pk)");
    bf16_t* O; int ldc; const float* bias; int split_cols; size_t split_stride; float scale0;
    __device__ __forceinline__ void operator()(const f32x4 (&acc)[2][2][4][2], const Unit& u, int wr, int wc, int fr, int fq) const {
        const int row0 = u.pm * BM + wr * 64 + fr; int colt = u.pn * BM; bf16_t* base = O;
        float sc = 1.f; if (split_cols) { const int t = colt / split_cols; base += (size_t)t * split_stride; colt -= t * split_cols; if (t == 0) sc = scale0; }
        const int col0 = colt + wc * 32 + 8 * fq, bcol0 = u.pn * BM + wc * 32 + 8 * fq;
        f32x4 bv[2][2];
#pragma unroll
        for (int bj = 0; bj < 2; ++bj)
#pragma unroll
            for (int n = 0; n < 2; ++n) bv[bj][n] = bias ? *(const f32x4*)(bias + bcol0 + bj * HALF + 4 * n) : (f32x4){0.f, 0.f, 0.f, 0.f};
#pragma unroll
        for (int ai = 0; ai < 2; ++ai)
#pragma unroll
            for (int m = 0; m < 4; ++m) { bf16_t* rowp = base + (size_t)(row0 + ai * HALF + m * 16) * ldc + col0;
#pragma unroll
                for (int bj = 0; bj < 2; ++bj) { f32x4 v0 = acc[ai][bj][m][0] + bv[bj][0], v1 = acc[ai][bj][m][1] + bv[bj][1];
                    if (ACT == 1) { f32x2 a = gelu_pk((f32x2){v0[0], v0[1]}), b = gelu_pk((f32x2){v0[2], v0[3]}), c = gelu_pk((f32x2){v1[0], v1[1]}), d = gelu_pk((f32x2){v1[2], v1[3]});
                        v0 = (f32x4){a.x, a.y, b.x, b.y}; v1 = (f32x4){c.x, c.y, d.x, d.y}; }
                    v0 = v0 * sc; v1 = v1 * sc; u32x4 w; w.x = cvt_pk_bf16(v0[0], v0[1]); w.y = cvt_pk_bf16(v0[2], v0[3]); w.z = cvt_pk_bf16(v1[0], v1[1]); w.w = cvt_pk_bf16(v1[2], v1[3]);
                    if constexpr (SC1) { asm volatile("global_store_dwordx4 %0, %1, off sc1\n\ts_nop 1" :: "v"(rowp + bj * HALF), "v"(w) : "memory"); }
                    else *(u32x4*)(rowp + bj * HALF) = w; } }
    }
};

struct EpiF32 {
    static constexpr bool PERM = false, AFTER_DRAIN = false;
    float* C; int ldc; const float* bias;
    __device__ __forceinline__ void operator()(const f32x4 (&acc)[2][2][4][2], const Unit& u, int wr, int wc, int fr, int fq) const {
        const int row0 = u.pm * BM + wr * 64 + fr, col0 = u.pn * BM + wc * 32 + 4 * fq;
        f32x4 bv[2][2];
#pragma unroll
        for (int bj = 0; bj < 2; ++bj)
#pragma unroll
            for (int n = 0; n < 2; ++n) bv[bj][n] = bias ? *(const f32x4*)(bias + col0 + bj * HALF + n * 16) : (f32x4){0.f, 0.f, 0.f, 0.f};
#pragma unroll
        for (int ai = 0; ai < 2; ++ai)
#pragma unroll
            for (int m = 0; m < 4; ++m) { float* rowp = C + (size_t)(row0 + ai * HALF + m * 16) * ldc + col0;
#pragma unroll
                for (int bj = 0; bj < 2; ++bj)
#pragma unroll
                    for (int n = 0; n < 2; ++n) *(f32x4*)(rowp + bj * HALF + n * 16) = acc[ai][bj][m][n] + bv[bj][n]; }
    }
};

template <class Epi, class Sched, bool ALIGN_EPI = false, bool SP2 = false>
__device__ __forceinline__ void gemm_phase(PG8_LAS unsigned char* lds, const Gemm g, const Sched& S, const Epi& E) {
    int tid_ = threadIdx.x; asm volatile("" : "+v"(tid_));
    const int tid = tid_, wid = __builtin_amdgcn_readfirstlane(tid >> 6), lane = tid & 63, wr = wid >> 2, wc = wid & 3, fr = lane & 15, fq = lane >> 4;
    const int K = g.K, nt = K / BK;
    unsigned voffA[2], voffB[2];
#pragma unroll
    for (int i = 0; i < 2; ++i) { int R, C; stage_rc(tid * 16 + i * 8192, R, C); const int Rb = Epi::PERM ? ((R & ~31) + perm32(R & 31)) : R;
        voffA[i] = (unsigned)(R * K + C) * 2u; voffB[i] = (unsigned)(Rb * K + C) * 2u; }
    const size_t kstep = (size_t)(BK * 2);
    const size_t hstep = (size_t)HALF * K * 2;
    const size_t tstep = 2 * hstep;
    const unsigned ldsw = (unsigned)wid * 1024u;
    const int aoff = lds_byte(wr * 64 + fr, fq * 8), boff = lds_byte(wc * 32 + fr, fq * 8);
#define PG8_SA(b, h) (((b) * 2 + (h)) * HTB)
#define PG8_SB(b, h) ((4 + (b) * 2 + (h)) * HTB)
#define PG8_STAGE(bufoff, gbase, voff) do { _Pragma("unroll") for (int _i = 0; _i < 2; ++_i) \
        __builtin_amdgcn_global_load_lds((const unsigned*)((const char*)(gbase) + (voff)[_i]), (PG8_LAS unsigned*)(lds + (bufoff) + ldsw + _i * 8192), 16, 0, 0); } while (0)
#define PG8_LDA(dst, b, h) do { _Pragma("unroll") for (int m = 0; m < 4; ++m) _Pragma("unroll") for (int k = 0; k < 2; ++k) dst[m][k] = *(const PG8_LAS bf16x8*)(lds + PG8_SA(b, h) + aoff + m * 2048 + k * 1024); } while (0)
#define PG8_LDB(dst, b, h) do { _Pragma("unroll") for (int n = 0; n < 2; ++n) _Pragma("unroll") for (int k = 0; k < 2; ++k) dst[n][k] = *(const PG8_LAS bf16x8*)(lds + PG8_SB(b, h) + boff + n * 2048 + k * 1024); } while (0)
#define PG8_MMA(ai, bj, At, Bt) do { __builtin_amdgcn_s_setprio(1); _Pragma("unroll") for (int m = 0; m < 4; ++m) _Pragma("unroll") for (int n = 0; n < 2; ++n) _Pragma("unroll") for (int k = 0; k < 2; ++k) \
        acc[ai][bj][m][n] = __builtin_amdgcn_mfma_f32_16x16x32_bf16(Bt[n][k], At[m][k], acc[ai][bj][m][n], 0, 0, 0); __builtin_amdgcn_s_setprio(0); } while (0)
#define PG8_WAIT_V(n) asm volatile("s_waitcnt vmcnt(" #n ")" ::: "memory")
#define PG8_WAIT_L(n) asm volatile("s_waitcnt lgkmcnt(" #n ")" ::: "memory")
#define PG8_BAR __builtin_amdgcn_s_barrier()
#define PG8_SCHED __builtin_amdgcn_sched_barrier(0)
    Unit cur, nxt; int ui = 0;
    if (!S.next(0, cur)) return;
    f32x4 acc[2][2][4][2];
#pragma unroll
    for (int a = 0; a < 2; ++a)
#pragma unroll
        for (int b = 0; b < 2; ++b)
#pragma unroll
            for (int m = 0; m < 4; ++m)
#pragma unroll
                for (int n = 0; n < 2; ++n) acc[a][b][m][n] = (f32x4){0.f, 0.f, 0.f, 0.f};
    bf16x8 At[4][2], B0[2][2], B1[2][2];
    const char* cA = (const char*)g.A + (size_t)cur.pm * tstep; const char* cB = (const char*)g.Bt + (size_t)cur.pn * tstep;
    S.a_ready(cur);
    if constexpr (SP2) {
        PG8_STAGE(PG8_SB(0, 0), cB, voffB); PG8_STAGE(PG8_SB(0, 1), cB + hstep, voffB); PG8_STAGE(PG8_SA(0, 0), cA, voffA); PG8_STAGE(PG8_SA(0, 1), cA + hstep, voffA);
        if (wr == 1) PG8_BAR;
        PG8_WAIT_V(2); PG8_BAR;
        PG8_STAGE(PG8_SB(1, 0), cB + kstep, voffB); PG8_STAGE(PG8_SA(1, 0), cA + kstep, voffA); PG8_STAGE(PG8_SB(1, 1), cB + hstep + kstep, voffB);
        PG8_WAIT_V(6); PG8_BAR;
    } else {
        PG8_STAGE(PG8_SB(0, 0), cB, voffB); PG8_STAGE(PG8_SA(0, 0), cA, voffA); PG8_STAGE(PG8_SB(0, 1), cB + hstep, voffB); PG8_STAGE(PG8_SA(0, 1), cA + hstep, voffA);
        if (wr == 1) PG8_BAR;
        PG8_WAIT_V(4); PG8_BAR;
        PG8_STAGE(PG8_SB(1, 0), cB + kstep, voffB); PG8_STAGE(PG8_SA(1, 0), cA + kstep, voffA); PG8_STAGE(PG8_SB(1, 1), cB + hstep + kstep, voffB);
        PG8_WAIT_V(6); PG8_BAR;
    }
    for (;;) {
        const bool has_next = S.next(ui + 1, nxt);
        const char* nA = has_next ? (const char*)g.A + (size_t)nxt.pm * tstep : cA; const char* nB = has_next ? (const char*)g.Bt + (size_t)nxt.pn * tstep : cB;
        for (int t = 0; t < nt; t += 2) {
            const bool last = (t == nt - 2);
            const char* a1 = cA + (size_t)(t + 1) * kstep;
            const char* a2 = last ? nA : cA + (size_t)(t + 2) * kstep; const char* b2 = last ? nB : cB + (size_t)(t + 2) * kstep;
            const char* a3 = a2 + kstep; const char* b3 = b2 + kstep;
            if (last && has_next) S.a_ready(nxt);
            if constexpr (SP2) {
            PG8_LDB(B0, 0, 0); PG8_LDB(B1, 0, 1); PG8_SCHED; PG8_LDA(At, 0, 0); PG8_STAGE(PG8_SA(1, 1), a1 + hstep, voffA);
            PG8_WAIT_V(8); PG8_WAIT_L(0); PG8_BAR; PG8_MMA(0, 0, At, B0); PG8_MMA(0, 1, At, B1); PG8_BAR; PG8_SCHED;
            PG8_LDA(At, 0, 1); PG8_STAGE(PG8_SB(0, 0), b2, voffB); PG8_STAGE(PG8_SB(0, 1), b2 + hstep, voffB); PG8_STAGE(PG8_SA(0, 0), a2, voffA);
            PG8_WAIT_V(8); PG8_WAIT_L(0); PG8_BAR; PG8_MMA(1, 0, At, B0); PG8_MMA(1, 1, At, B1); PG8_BAR; PG8_SCHED;
            PG8_LDB(B0, 1, 0); PG8_LDB(B1, 1, 1); PG8_SCHED; PG8_LDA(At, 1, 0); PG8_STAGE(PG8_SA(0, 1), a2 + hstep, voffA);
            PG8_WAIT_V(8); PG8_WAIT_L(0); PG8_BAR; PG8_MMA(0, 0, At, B0); PG8_MMA(0, 1, At, B1); PG8_BAR; PG8_SCHED;
            PG8_LDA(At, 1, 1); PG8_STAGE(PG8_SB(1, 0), b3, voffB); PG8_STAGE(PG8_SB(1, 1), b3 + hstep, voffB); PG8_STAGE(PG8_SA(1, 0), a3, voffA);
            PG8_WAIT_V(8); PG8_WAIT_L(0); PG8_BAR; PG8_MMA(1, 0, At, B0); PG8_MMA(1, 1, At, B1); PG8_BAR; PG8_SCHED;
            } else {
            PG8_LDB(B0, 0, 0); PG8_SCHED; PG8_LDA(At, 0, 0); PG8_STAGE(PG8_SA(1, 1), a1 + hstep, voffA);
            PG8_WAIT_L(8); PG8_BAR; PG8_WAIT_L(0); PG8_MMA(0, 0, At, B0); PG8_BAR; PG8_SCHED;
            PG8_LDB(B1, 0, 1); PG8_STAGE(PG8_SB(0, 0), b2, voffB);
            PG8_BAR; PG8_WAIT_L(0); PG8_MMA(0, 1, At, B1); PG8_BAR;
            PG8_LDA(At, 0, 1); PG8_STAGE(PG8_SA(0, 0), a2, voffA);
            PG8_BAR; PG8_WAIT_L(0); PG8_MMA(1, 0, At, B0); PG8_BAR; PG8_SCHED;
            PG8_STAGE(PG8_SB(0, 1), b2 + hstep, voffB);
            PG8_WAIT_V(6); PG8_BAR; PG8_MMA(1, 1, At, B1); PG8_BAR;
            PG8_LDB(B0, 1, 0); PG8_SCHED; PG8_LDA(At, 1, 0); PG8_STAGE(PG8_SA(0, 1), a2 + hstep, voffA);
            PG8_WAIT_L(8); PG8_BAR; PG8_WAIT_L(0); PG8_MMA(0, 0, At, B0); PG8_BAR; PG8_SCHED;
            PG8_LDB(B1, 1, 1); PG8_STAGE(PG8_SB(1, 0), b3, voffB);
            PG8_BAR; PG8_WAIT_L(0); PG8_MMA(0, 1, At, B1); PG8_BAR;
            PG8_LDA(At, 1, 1); PG8_STAGE(PG8_SA(1, 0), a3, voffA);
            PG8_BAR; PG8_WAIT_L(0); PG8_MMA(1, 0, At, B0); PG8_BAR; PG8_SCHED;
            PG8_STAGE(PG8_SB(1, 1), b3 + hstep, voffB);
            PG8_WAIT_V(6); PG8_BAR; PG8_MMA(1, 1, At, B1); PG8_BAR;
            }
        }
        if constexpr (ALIGN_EPI) { if (wr == 0) PG8_BAR; }
        if constexpr (!Epi::AFTER_DRAIN) { E(acc, cur, wr, wc, fr, fq); S.done(cur); }
        if (!has_next) break;
#pragma unroll
        for (int a = 0; a < 2; ++a)
#pragma unroll
            for (int b = 0; b < 2; ++b)
#pragma unroll
                for (int m = 0; m < 4; ++m)
#pragma unroll
                    for (int n = 0; n < 2; ++n) acc[a][b][m][n] = (f32x4){0.f, 0.f, 0.f, 0.f};
        cur = nxt; cA = nA; cB = nB; ++ui;
        if constexpr (ALIGN_EPI) { if (wr == 1) PG8_BAR; }
    }
    PG8_WAIT_V(0);
    if constexpr (!ALIGN_EPI) { if (wr == 0) PG8_BAR; }
    PG8_BAR;
    if constexpr (Epi::AFTER_DRAIN) { E.fused(acc, cur, wr, wc, fr, fq, lds, wid, lane); S.done(cur); }
#undef PG8_SA
#undef PG8_SB
#undef PG8_STAGE
#undef PG8_LDA
#undef PG8_LDB
#undef PG8_MMA
#undef PG8_WAIT_V
#undef PG8_WAIT_L
#undef PG8_BAR
#undef PG8_SCHED
}
}
#define GAS __attribute__((address_space(1)))
#define LAS __attribute__((address_space(3)))
typedef unsigned short bf16;
typedef unsigned v4u __attribute__((ext_vector_type(4)));
typedef float f32x4 __attribute__((ext_vector_type(4)));
typedef short bf16x8 __attribute__((ext_vector_type(8)));
typedef GAS unsigned gu32;
typedef GAS unsigned long long gu64;
#define RLX_AGENT __ATOMIC_RELAXED, __HIP_MEMORY_SCOPE_AGENT
#define LDS_WAIT() asm volatile("s_waitcnt lgkmcnt(0)" ::: "memory")
#define VM_WAIT() asm volatile("s_waitcnt vmcnt(0)" ::: "memory")
__device__ __forceinline__ unsigned long long rt() { return __builtin_amdgcn_s_memrealtime(); }
__device__ __forceinline__ unsigned f2bf(float f) { unsigned u = __builtin_bit_cast(unsigned, f); return (u + 0x7fffu + ((u >> 16) & 1u)) >> 16; }
__device__ __forceinline__ unsigned pk2(float lo, float hi) { return f2bf(lo) | (f2bf(hi) << 16); }
#define XB_TMO      128
#define XB_XCNT(j)  (256  + 64 * (j))
#define XB_XSUB(j)  (1280 + 64 * (j))
#define XB_XGEN(j)  (2304 + 64 * (j))
#define XB_TOP      3328
#define XB_TOPGEN   3392
#define XCD_BAR_WORDS 3456
#define XB_SPIN_CAP (1u << 24)

__device__ __forceinline__ unsigned xb_ld(unsigned* p)              { return __hip_atomic_load(p, __ATOMIC_RELAXED, __HIP_MEMORY_SCOPE_AGENT); }
__device__ __forceinline__ unsigned xb_add(unsigned* p, unsigned v) { return __hip_atomic_fetch_add(p, v, __ATOMIC_RELAXED, __HIP_MEMORY_SCOPE_AGENT); }
__device__ __forceinline__ unsigned xb_xcc_id() { return (unsigned)__builtin_amdgcn_s_getreg((3 << 11) | 20) & 0xFu; }
#define XB_SPIN(cond, bar) do { unsigned _sp = 0; while (cond) { __builtin_amdgcn_s_sleep(1); \
    if ((++_sp & 255u) == 0u) { if (xb_ld(&(bar)[XB_TMO])) break; if (_sp > XB_SPIN_CAP) { atomicAdd(&(bar)[XB_TMO], 1u); break; } } } } while (0)

struct XcdBarrier {
    unsigned* bar; unsigned x;
    volatile LAS unsigned* st;
};

__device__ __forceinline__ XcdBarrier xcd_barrier_post(unsigned* bar, volatile LAS unsigned* st) {
    XcdBarrier b; b.bar = bar; b.x = xb_xcc_id(); b.st = st;
    if (threadIdx.x == 0) (void)xb_add(&bar[XB_XCNT(b.x)], 1u);
    return b;
}
__device__ __forceinline__ void xcd_barrier_complete(unsigned* bar, unsigned x, unsigned& nloc, unsigned& nx) {
    const unsigned G = gridDim.x * gridDim.y * gridDim.z;
    unsigned sum, cnt, mine, sp = 0u;
    for (;;) {
        sum = 0u; cnt = 0u; mine = 0u;
#pragma unroll
        for (unsigned j = 0; j < 16; ++j) { const unsigned c = xb_ld(&bar[XB_XCNT(j)]); sum += c; cnt += (c > 0u) ? 1u : 0u; mine = (j == x) ? c : mine; }
        if (sum == G) break;
        __builtin_amdgcn_s_sleep(1);
        if ((++sp & 255u) == 0u) { if (xb_ld(&bar[XB_TMO])) break; if (sp > XB_SPIN_CAP) { atomicAdd(&bar[XB_TMO], 1u); break; } }
    }
    nloc = mine > 0u ? mine : 1u; nx = cnt > 0u ? cnt : 1u;
}

__device__ __forceinline__ void xcd_barrier(const XcdBarrier& b) {
    asm volatile("s_waitcnt vmcnt(0)" ::: "memory");
    __syncthreads();
    if (threadIdx.x == 0) {
        unsigned* bar = b.bar;
        __builtin_amdgcn_s_waitcnt(0);
        unsigned nloc = b.st[0], nx = b.st[1];
        if (nloc == 0u) { xcd_barrier_complete(bar, b.x, nloc, nx); b.st[0] = nloc; b.st[1] = nx; }
        const unsigned old = xb_add(&bar[XB_XSUB(b.x)], 1u);
        const unsigned gen = old / nloc;
        if (old + 1u == (gen + 1u) * nloc) {
            __builtin_amdgcn_fence(__ATOMIC_RELEASE, "agent");
            asm volatile("s_waitcnt vmcnt(0)" ::: "memory");
            const unsigned og = xb_add(&bar[XB_TOP], 1u);
            const unsigned tg = og / nx;
            if (og + 1u == (tg + 1u) * nx) xb_add(&bar[XB_TOPGEN], 1u);
            else XB_SPIN(xb_ld(&bar[XB_TOPGEN]) == tg, bar);
            __builtin_amdgcn_fence(__ATOMIC_ACQUIRE, "agent");
            xb_add(&bar[XB_XGEN(b.x)], 1u);
            asm volatile("s_waitcnt vmcnt(0)" ::: "memory");
        } else {
            XB_SPIN(xb_ld(&bar[XB_XGEN(b.x)]) == gen, bar);
            __builtin_amdgcn_fence(__ATOMIC_ACQUIRE, "agent");
            asm volatile("s_waitcnt vmcnt(0)" ::: "memory");
        }
    }
    __syncthreads();
}
#include <hip/hip_bf16.h>
#include <cmath>
namespace attn_body {
using bf16=__hip_bfloat16;
using bf16x8=__attribute__((ext_vector_type(8)))short;
using s16x4=__attribute__((ext_vector_type(4)))short;
using f32x16=__attribute__((ext_vector_type(16)))float;
using u32x4=__attribute__((ext_vector_type(4)))unsigned;
constexpr int NHEAD=16,D=64,DM=NHEAD*D;
constexpr int NW=8,QBLK=32,QB=QBLK*NW,KVBLK=64;
constexpr int ATTN_PITCH=DM, ATTN_UNIT_ROWS=QB;
__device__ __forceinline__ int crow(int r,int hi){return (r&3)+8*(r>>2)+4*hi;}
#define SBAR() __builtin_amdgcn_sched_barrier(0)
__device__ __forceinline__ void cmask(f32x16&p0,f32x16&p1,int jb,int qrel,int hi){
  const float NEG=-INFINITY; int kb=64*jb+4*hi;
  #pragma unroll
  for(int r=0;r<16;++r){int kv=kb+(r&3)+8*(r>>2); if(kv>qrel)p0[r]=NEG; if(kv+32>qrel)p1[r]=NEG;}
}

constexpr int NSLOT=3, SLOTB=8192;
constexpr int MAXKEYS=2048;
constexpr int LDS_K=0, LDS_V=NSLOT*SLOTB, LDS_WS=2*NSLOT*SLOTB, LDS_OST=LDS_WS+NW*64*4, LDS_BIAS=LDS_OST+NW*4096, LDS_BYTES=LDS_BIAS+MAXKEYS*4;
constexpr float C2=0.125f*1.4426950408889634f;
__device__ __forceinline__ void glds16(const void*gsrc,unsigned lds_dst){unsigned keep;
  asm volatile("s_mov_b32 %0, m0\n\ts_mov_b32 m0, %2\n\ts_nop 0\n\tglobal_load_lds_dwordx4 %1, off\n\ts_mov_b32 m0, %0":"=&s"(keep):"v"(gsrc),"s"(lds_dst):"memory");}
__device__ __forceinline__ float max3f(float a,float b,float c){float r;asm("v_max3_f32 %0, %1, %2, %3":"=v"(r):"v"(a),"v"(b),"v"(c));return r;}
__device__ __forceinline__ float max2f(float a,float b){float r;asm("v_max_f32_e32 %0, %1, %2":"=v"(r):"v"(a),"v"(b));return r;}
__device__ __forceinline__ float fadd_s(float a,float b){float r;asm("v_add_f32_e32 %0, %1, %2":"=v"(r):"v"(a),"v"(b));return r;}
__device__ __forceinline__ float fsub_s(float a,float b){float r;asm("v_sub_f32_e32 %0, %1, %2":"=v"(r):"v"(a),"v"(b));return r;}
typedef float f32x2_t __attribute__((ext_vector_type(2))); typedef __bf16 bf16x2_t __attribute__((ext_vector_type(2)));
__device__ __forceinline__ unsigned cvtpk_s(float lo,float hi){f32x2_t v={lo,hi};bf16x2_t b=__builtin_convertvector(v,bf16x2_t);return __builtin_bit_cast(unsigned,b);}
#define WAIT_BAR(N) asm volatile("s_waitcnt vmcnt(" #N ") lgkmcnt(0)\n\ts_barrier":::"memory")

__device__ __forceinline__ void qkt(f32x16&p0,f32x16&p1,const char*Kslot,const bf16x8*qr,bf16x8 kxa,bf16x8 kxb,bf16x8 qx,int r32,int hi){
  const f32x16 zero16=f32x16{};
  const char*kb=Kslot+hi*1024+r32*16;
  #pragma unroll
  for(int d0=0;d0<4;++d0){
    const bf16x8 b0=*reinterpret_cast<const bf16x8*>(kb+d0*2048);
    const bf16x8 b1=*reinterpret_cast<const bf16x8*>(kb+d0*2048+512);
    if(d0==0){p0=__builtin_amdgcn_mfma_f32_32x32x16_bf16(b0,qr[0],zero16,0,0,0);p1=__builtin_amdgcn_mfma_f32_32x32x16_bf16(b1,qr[0],zero16,0,0,0);}
    else{p0=__builtin_amdgcn_mfma_f32_32x32x16_bf16(b0,qr[d0],p0,0,0,0);p1=__builtin_amdgcn_mfma_f32_32x32x16_bf16(b1,qr[d0],p1,0,0,0);}}
  p0=__builtin_amdgcn_mfma_f32_32x32x16_bf16(kxa,qx,p0,0,0,0);p1=__builtin_amdgcn_mfma_f32_32x32x16_bf16(kxb,qx,p1,0,0,0);
}
typedef __attribute__((address_space(3))) const char* lds_cptr;
typedef short v4i16_t __attribute__((ext_vector_type(4)));
__device__ __forceinline__ void kload8(bf16x8*kf,lds_cptr kp){
  kf[0]=*(const __attribute__((address_space(3))) bf16x8*)(kp);      kf[1]=*(const __attribute__((address_space(3))) bf16x8*)(kp+512);
  kf[2]=*(const __attribute__((address_space(3))) bf16x8*)(kp+2048); kf[3]=*(const __attribute__((address_space(3))) bf16x8*)(kp+2560);
  kf[4]=*(const __attribute__((address_space(3))) bf16x8*)(kp+4096); kf[5]=*(const __attribute__((address_space(3))) bf16x8*)(kp+4608);
  kf[6]=*(const __attribute__((address_space(3))) bf16x8*)(kp+6144); kf[7]=*(const __attribute__((address_space(3))) bf16x8*)(kp+6656);
}
__device__ __forceinline__ void kload2(bf16x8*kf,lds_cptr kp,int j){ kf[2*j]=*(const __attribute__((address_space(3))) bf16x8*)(kp+j*2048); kf[2*j+1]=*(const __attribute__((address_space(3))) bf16x8*)(kp+j*2048+512); }
__device__ __forceinline__ s16x4 vtr(lds_cptr p){ return __builtin_bit_cast(s16x4,__builtin_amdgcn_ds_read_tr16_b64_v4i16((__attribute__((address_space(3))) v4i16_t*)p)); }
__device__ __forceinline__ float rowmax(const f32x16&p0,const f32x16&p1){
  float a=max3f(p0[0],p0[1],p1[0]),b=max3f(p0[2],p0[3],p1[1]);a=max3f(a,p1[2],p1[3]);
  #pragma unroll
  for(int r=4;r<16;r+=4){a=max3f(a,p0[r],p0[r+1]);b=max3f(b,p0[r+2],p0[r+3]);a=max3f(a,p1[r],p1[r+1]);b=max3f(b,p1[r+2],p1[r+3]);}
  const float m=max2f(a,b);
  auto rr=__builtin_amdgcn_permlane32_swap(__float_as_uint(m),__float_as_uint(m),false,false);
  return max2f(__uint_as_float(rr[0]),__uint_as_float(rr[1]));
}
__device__ __forceinline__ void pv(f32x16*o,int vb,bf16x8 pa0,bf16x8 pa1,bf16x8 pa2,bf16x8 pa3){
  #pragma unroll
  for(int d0=0;d0<2;++d0){s16x4 lo[4],hi[4];
    #pragma unroll
    for(int ks=0;ks<4;++ks){
      asm volatile("ds_read_b64_tr_b16 %0,%1 offset:%c2":"=&v"(lo[ks]):"v"(vb),"i"(d0*4096+ks*1024):"memory");
      asm volatile("ds_read_b64_tr_b16 %0,%1 offset:%c2":"=&v"(hi[ks]):"v"(vb),"i"(d0*4096+ks*1024+512):"memory");}
    asm volatile("s_waitcnt lgkmcnt(0)":::"memory");SBAR();
    #define PK(k) (bf16x8){lo[k][0],lo[k][1],lo[k][2],lo[k][3],hi[k][0],hi[k][1],hi[k][2],hi[k][3]}
    o[d0]=__builtin_amdgcn_mfma_f32_32x32x16_bf16(pa0,PK(0),o[d0],0,0,0);
    o[d0]=__builtin_amdgcn_mfma_f32_32x32x16_bf16(pa1,PK(1),o[d0],0,0,0);
    o[d0]=__builtin_amdgcn_mfma_f32_32x32x16_bf16(pa2,PK(2),o[d0],0,0,0);
    o[d0]=__builtin_amdgcn_mfma_f32_32x32x16_bf16(pa3,PK(3),o[d0],0,0,0);
    #undef PK
  }
}

#ifndef ATTN_STORE16
#define ATTN_STORE16(p,v) (*(u32x4*)(p)=(v))
#endif
__device__ __forceinline__ void split3(float c,unsigned&h,unsigned&m,unsigned&l){ const unsigned cb=__float_as_uint(c); h=cb&0xffff0000u; const float r1=c-__uint_as_float(h); const unsigned r1b=__float_as_uint(r1); m=r1b&0xffff0000u; const float r2=r1-__uint_as_float(m); l=__float_as_uint(r2)&0xffff0000u; }
__device__ __forceinline__ bf16x8 kx_frag(float bias,int hi){ unsigned h,m,l; split3(bias,h,m,l); u32x4 w; w.x=hi?0u:((h>>16)|m); w.y=hi?0u:((l>>16)|0x3f800000u); w.z=hi?0u:0x3f803f80u; w.w=0u; return __builtin_bit_cast(bf16x8,w); }
__device__ __forceinline__ bf16x8 qx_frag(float nref,int hi){ unsigned h,m,l; split3(nref,h,m,l); u32x4 w; w.x=hi?0u:0x3f803f80u; w.y=hi?0u:(0x3f80u|h); w.z=hi?0u:((m>>16)|l); w.w=0u; return __builtin_bit_cast(bf16x8,w); }
template<int THRL> __device__ __forceinline__ void attn_unit(int q0,const bf16*Qw,const bf16*__restrict__ Kh,const bf16*__restrict__ Vh,const bf16*Gw,bf16*Ow,const float*__restrict__ biasg,int nbias,bool st_ok,char*shm){
  int tid_=threadIdx.x; asm volatile("":"+v"(tid_));
  const int tid=tid_,lane=tid&63,r32=lane&31,hi=lane>>5; const int wid=__builtin_amdgcn_readfirstlane(tid>>6);
  float*biasL=(float*)(shm+LDS_BIAS);
  for(int i=tid;i<nbias;i+=NW*64)biasL[i]=biasg[i];
  const unsigned lds0=(unsigned)(uintptr_t)shm;
  float*wsf=(float*)(shm+LDS_WS)+wid*64;
  const bf16*ksrc=Kh+(long)lane*DM+wid*8;
  const bf16*vsrc=Vh+(long)(16*(wid&3)+(lane>>2))*DM+(wid>>2)*32+(lane&3)*8;
  const unsigned kdst=lds0+LDS_K+wid*1024, vdst=lds0+LDS_V+wid*1024;
  #define DMA_K(t,slot) glds16(ksrc+(long)(t)*KVBLK*DM,(unsigned)__builtin_amdgcn_readfirstlane(kdst+(slot)))
  #define DMA_V(t,slot) glds16(vsrc+(long)(t)*KVBLK*DM,(unsigned)__builtin_amdgcn_readfirstlane(vdst+(slot)))
  const int vb0=(int)(lds0+LDS_V)+((lane>>4)&1)*32+(lane&3)*8+(4*hi+((lane&15)>>2))*64;
  const char*Kbase=shm+LDS_K; bf16x8 kf[8];
  const lds_cptr shm3=(lds_cptr)shm; const lds_cptr kp0=shm3+LDS_K+hi*1024+r32*16; const lds_cptr vp0=shm3+LDS_V+((lane>>4)&1)*32+(lane&3)*8+(4*hi+((lane&15)>>2))*64;
  const int NT=(q0+QB)/KVBLK;
  if(!st_ok){
    int sc_=0,sn_=SLOTB;
    #define IROT() do{sc_=sn_;sn_=(sn_==(NSLOT-1)*SLOTB)?0:sn_+SLOTB;}while(0)
    #define IDLE(t,GK,GV) do{ if(GK){DMA_K((t)+3,sc_);} if(GV){DMA_V((t)+1,sn_);} }while(0)
    #define IENDW(tt) do{ if((tt)+3<NT){WAIT_BAR(2);} else if((tt)+2<NT){WAIT_BAR(1);} else {WAIT_BAR(0);} }while(0)
    DMA_K(0,0);DMA_V(0,0);DMA_K(1,SLOTB);DMA_K(2,2*SLOTB); WAIT_BAR(3);
    WAIT_BAR(0); DMA_K(3,0);DMA_V(1,SLOTB); IROT(); WAIT_BAR(2);
    int ti=1;
    for(;ti+5<NT;ti+=2){ IDLE(ti,true,true); WAIT_BAR(2); IROT(); IDLE(ti+1,true,true); WAIT_BAR(2); IROT(); }
    for(;ti+1<NT;ti+=2){ IDLE(ti,(ti+3<NT),(ti+1<NT)); IENDW(ti); IROT(); IDLE(ti+1,(ti+4<NT),(ti+2<NT)); IENDW(ti+1); IROT(); }
    asm volatile("s_waitcnt vmcnt(0) lgkmcnt(0)\n\ts_barrier":::"memory");
    #undef IROT
    #undef IDLE
    #undef IENDW
    return;
  }
  DMA_K(0,0);DMA_V(0,0);DMA_K(1,SLOTB);
  bf16x8 qr[4];
  #pragma unroll
  for(int d0=0;d0<4;++d0)qr[d0]=*reinterpret_cast<const bf16x8*>(&Qw[(long)r32*DM+d0*16+hi*8]);
  u32x4 gpre[4];
  #pragma unroll
  for(int i=0;i<4;++i)gpre[i]=st_ok?*(const u32x4*)(Gw+(long)(i*8+(lane>>3))*DM+(lane&7)*8):(u32x4){0u,0u,0u,0u};
  float mhat=0.f,l_reg=0.f;f32x16 o[2];o[0]=f32x16{};o[1]=f32x16{}; bf16x8 qx=qx_frag(0.f,hi); const f32x16 zero16=f32x16{};
  const int qrel=wid*QBLK+r32;
  #define CMASK(P0,P1,t) do{int jb_=(t)-(NT-4); if(jb_>=0)cmask(P0,P1,jb_,qrel,hi);}while(0)
  bool resc=false;
  #define START(P0,P1) do{ const float rm=rowmax(P0,P1); resc=false; \
    { const float dl=rm; mhat=fadd_s(mhat,dl); \
      _Pragma("unroll") for(int r=0;r<16;++r){P0[r]=fsub_s(P0[r],dl);P1[r]=fsub_s(P1[r],dl);} \
      qx=qx_frag(-mhat,hi); } \
    _Pragma("unroll") for(int r=0;r<16;++r)P0[r]=__builtin_amdgcn_exp2f(P0[r]); }while(0)
  #define RESC() do{ if(resc){ asm volatile("s_waitcnt lgkmcnt(0)":::"memory"); \
      _Pragma("unroll") for(int d_=0;d_<2;++d_) _Pragma("unroll") for(int r=0;r<16;++r)o[d_][r]*=wsf[crow(r,hi)]; } }while(0)
  f32x16 pA0,pA1,pB0,pB1;
  int sl_prev=0,sl_cur=0,sl_next=SLOTB;
  #define ROT() do{sl_prev=sl_cur;sl_cur=sl_next;sl_next=(sl_next==(NSLOT-1)*SLOTB)?0:sl_next+SLOTB;}while(0)
  DMA_K(2,2*SLOTB);
  WAIT_BAR(3);
  qkt(pA0,pA1,Kbase,qr,kx_frag(biasL[r32],hi),kx_frag(biasL[32+r32],hi),qx,r32,hi);asm volatile("s_nop 15\n\ts_nop 7":"+v"(pA0),"+v"(pA1));CMASK(pA0,pA1,0);
  START(pA0,pA1);
  _Pragma("unroll") for(int r=0;r<16;++r)pA1[r]=__builtin_amdgcn_exp2f(pA1[r]);
  WAIT_BAR(0);
  DMA_K(3,0);DMA_V(1,SLOTB);
  ROT();
  kload8(kf,kp0+sl_cur);
  WAIT_BAR(2);
  s16x4 vlo[8],vhi[8]; u32x4 pw0,pw1,pw2,pw3;
  #define PKW(P,B) cvtpk_s(P[B],P[B+1])
  #define PAF(k) __builtin_bit_cast(bf16x8,pw##k)
  #define VFR(i) (bf16x8){vlo[i][0],vlo[i][1],vlo[i][2],vlo[i][3],vhi[i][0],vhi[i][1],vhi[i][2],vhi[i][3]}
  #define PIN(x) asm volatile("":"+v"(x))
  #define MX3(a,b,c) __builtin_fmaxf(__builtin_fmaxf((a),(b)),(c))
  #define GAPA(MF,A0,A1,A2,A3,W0,W1,PW) do{ MF; sacc+=A0; sacc+=A1; sacc+=A2; sacc+=A3; PIN(sacc); W0; W1; PIN(PW); SBAR(); }while(0)
  #define EX(v) __builtin_amdgcn_exp2f(v)
  #define GAPB(MF,X,B) do{ MF; X[B]=EX(X[B]); X[B+1]=EX(X[B+1]); X[B+2]=EX(X[B+2]); X[B+3]=EX(X[B+3]); PIN(X); SBAR(); }while(0)
  #define VRD(i) do{ vlo[i]=vtr(vp_+(((i)>>2)*4096+((i)&3)*1024)); vhi[i]=vtr(vp_+(((i)>>2)*4096+((i)&3)*1024+512)); }while(0)
  #define KRD(G,j) do{ if(G){ kload2(kf,kp0+sl_next,j); SBAR(); } }while(0)
  #define STEP(C0,C1,P0,P1,t,GK,GV,GL) do{ SBAR(); \
    const lds_cptr vp_=vp0+sl_prev; const float bia_=biasL[(t)*KVBLK+r32], bib_=biasL[(t)*KVBLK+32+r32]; \
    VRD(0); SBAR(); float sacc=(P0[0]+P0[1]); \
    GAPA(C0=__builtin_amdgcn_mfma_f32_32x32x16_bf16(kf[0],qr[0],zero16,0,0,0), P0[2],P0[3],P0[4],P0[5],     pw0[0]=PKW(P0,0), pw0[1]=PKW(P0,2), pw0); \
    VRD(4); SBAR(); GAPA(C1=__builtin_amdgcn_mfma_f32_32x32x16_bf16(kf[1],qr[0],zero16,0,0,0), P0[6],P0[7],P0[8],P0[9],     pw0[2]=PKW(P0,4), pw0[3]=PKW(P0,6), pw0); \
    VRD(1); SBAR(); GAPA(C0=__builtin_amdgcn_mfma_f32_32x32x16_bf16(kf[2],qr[1],C0,0,0,0),   P0[10],P0[11],P0[12],P0[13], pw1[0]=PKW(P0,8), pw1[1]=PKW(P0,10), pw1); \
    VRD(5); SBAR(); GAPA(C1=__builtin_amdgcn_mfma_f32_32x32x16_bf16(kf[3],qr[1],C1,0,0,0),   P0[14],P0[15],P1[0],P1[1],   pw1[2]=PKW(P0,12),pw1[3]=PKW(P0,14), pw1); \
    VRD(2); SBAR(); GAPA(C0=__builtin_amdgcn_mfma_f32_32x32x16_bf16(kf[4],qr[2],C0,0,0,0),   P1[2],P1[3],P1[4],P1[5],     pw2[0]=PKW(P1,0), pw2[1]=PKW(P1,2), pw2); \
    VRD(6); SBAR(); GAPA(C1=__builtin_amdgcn_mfma_f32_32x32x16_bf16(kf[5],qr[2],C1,0,0,0),   P1[6],P1[7],P1[8],P1[9],     pw2[2]=PKW(P1,4), pw2[3]=PKW(P1,6), pw2); \
    VRD(3); SBAR(); GAPA(C0=__builtin_amdgcn_mfma_f32_32x32x16_bf16(kf[6],qr[3],C0,0,0,0),   P1[10],P1[11],P1[12],P1[13], pw3[0]=PKW(P1,8), pw3[1]=PKW(P1,10), pw3); \
    VRD(7); SBAR(); GAPA(C1=__builtin_amdgcn_mfma_f32_32x32x16_bf16(kf[7],qr[3],C1,0,0,0),   P1[14],P1[15],0.f,0.f,       pw3[2]=PKW(P1,12),pw3[3]=PKW(P1,14), pw3); \
    { const bf16x8 kxa_=kx_frag(bia_,hi), kxb_=kx_frag(bib_,hi); C0=__builtin_amdgcn_mfma_f32_32x32x16_bf16(kxa_,qx,C0,0,0,0); C1=__builtin_amdgcn_mfma_f32_32x32x16_bf16(kxb_,qx,C1,0,0,0); } SBAR(); \
    l_reg+=sacc; \
    if(GK){DMA_K((t)+3,sl_cur);} if(GV){DMA_V((t)+1,sl_next);} \
    CMASK(C0,C1,t); \
    { float a=MX3(C0[0],C0[1],C1[0]),b=MX3(C0[2],C0[3],C1[1]); a=MX3(a,C1[2],C1[3]); \
      _Pragma("unroll") for(int r=4;r<16;r+=4){a=MX3(a,C0[r],C0[r+1]);b=MX3(b,C0[r+2],C0[r+3]);a=MX3(a,C1[r],C1[r+1]);b=MX3(b,C1[r+2],C1[r+3]);} \
      float rm=__builtin_fmaxf(a,b); { auto rr=__builtin_amdgcn_permlane32_swap(__float_as_uint(rm),__float_as_uint(rm),false,false); rm=__builtin_fmaxf(__uint_as_float(rr[0]),__uint_as_float(rr[1])); } \
      resc=false; \
      if(__builtin_expect(__any(rm>(float)THRL),0)){ const float dl=__builtin_fmaxf(rm,0.f); mhat+=dl; \
        _Pragma("unroll") for(int r=0;r<16;++r){C0[r]-=dl;C1[r]-=dl;} \
        qx=qx_frag(-mhat,hi); \
        const float f=__builtin_amdgcn_exp2f(-dl); l_reg*=f; if(hi==0)wsf[r32]=f; resc=true; } } \
    SBAR(); \
    GAPB(o[0]=__builtin_amdgcn_mfma_f32_32x32x16_bf16(PAF(0),VFR(0),o[0],0,0,0), C0,0); \
    GAPB(o[1]=__builtin_amdgcn_mfma_f32_32x32x16_bf16(PAF(0),VFR(4),o[1],0,0,0), C0,4); \
    KRD(GL,0); GAPB(o[0]=__builtin_amdgcn_mfma_f32_32x32x16_bf16(PAF(1),VFR(1),o[0],0,0,0), C0,8); \
    KRD(GL,1); GAPB(o[1]=__builtin_amdgcn_mfma_f32_32x32x16_bf16(PAF(1),VFR(5),o[1],0,0,0), C0,12); \
    KRD(GL,2); GAPB(o[0]=__builtin_amdgcn_mfma_f32_32x32x16_bf16(PAF(2),VFR(2),o[0],0,0,0), C1,0); \
    KRD(GL,3); GAPB(o[1]=__builtin_amdgcn_mfma_f32_32x32x16_bf16(PAF(2),VFR(6),o[1],0,0,0), C1,4); \
    GAPB(o[0]=__builtin_amdgcn_mfma_f32_32x32x16_bf16(PAF(3),VFR(3),o[0],0,0,0), C1,8); \
    GAPB(o[1]=__builtin_amdgcn_mfma_f32_32x32x16_bf16(PAF(3),VFR(7),o[1],0,0,0), C1,12); \
    }while(0)
  int t=1;
  #undef CMASK
  #define CMASK(P0,P1,t) do{}while(0)
  for(;t+5<NT;t+=2){
    STEP(pB0,pB1,pA0,pA1,t,true,true,true);     WAIT_BAR(2); RESC(); ROT();
    STEP(pA0,pA1,pB0,pB1,t+1,true,true,true);   WAIT_BAR(2); RESC(); ROT();
  }
  #undef CMASK
  #define CMASK(P0,P1,t) do{int jb_=(t)-(NT-4); if(jb_>=0)cmask(P0,P1,jb_,qrel,hi);}while(0)
  #define ENDW(tt) do{ if((tt)+3<NT){WAIT_BAR(2);} else if((tt)+2<NT){WAIT_BAR(1);} else {WAIT_BAR(0);} }while(0)
  for(;t+1<NT;t+=2){
    STEP(pB0,pB1,pA0,pA1,t,(t+3<NT),(t+1<NT),(t+1<NT));       ENDW(t);   RESC(); ROT();
    STEP(pA0,pA1,pB0,pB1,t+1,(t+4<NT),(t+2<NT),(t+2<NT));     ENDW(t+1); RESC(); ROT();
  }
  STEP(pB0,pB1,pA0,pA1,NT-1,false,false,false); RESC();
  { float sacc=pB0[0]+pB0[1]; _Pragma("unroll") for(int r=2;r<16;++r)sacc+=pB0[r]; _Pragma("unroll") for(int r=0;r<16;++r)sacc+=pB1[r]; l_reg+=sacc;
    pw0=(u32x4){PKW(pB0,0),PKW(pB0,2),PKW(pB0,4),PKW(pB0,6)};pw1=(u32x4){PKW(pB0,8),PKW(pB0,10),PKW(pB0,12),PKW(pB0,14)};pw2=(u32x4){PKW(pB1,0),PKW(pB1,2),PKW(pB1,4),PKW(pB1,6)};pw3=(u32x4){PKW(pB1,8),PKW(pB1,10),PKW(pB1,12),PKW(pB1,14)};
    SBAR(); pv(o,vb0+sl_cur,PAF(0),PAF(1),PAF(2),PAF(3)); }
  #undef PKW
  #undef PAF
  #undef VFR
  #undef PIN
  #undef MX3
  #undef GAPA
  #undef GAPB
  #undef EX
  #undef VRD
  #undef KRD
  #undef STEP
  #undef ENDW
  {auto rr=__builtin_amdgcn_permlane32_swap(__float_as_uint(l_reg),__float_as_uint(l_reg),false,false);l_reg=__uint_as_float(rr[0])+__uint_as_float(rr[1]);}
  if(hi==0)wsf[32+r32]=l_reg;asm volatile("s_waitcnt lgkmcnt(0)":::"memory");
  float rli[16];
  #pragma unroll
  for(int r=0;r<16;++r)rli[r]=__builtin_amdgcn_rcpf(wsf[32+crow(r,hi)]);
  { bf16*stg=(bf16*)(shm+LDS_OST)+wid*2048;
    #pragma unroll
    for(int r=0;r<16;++r){const int orow=crow(r,hi);
      #pragma unroll
      for(int d0=0;d0<2;++d0)stg[orow*64+d0*32+r32]=__float2bfloat16(o[d0][r]*rli[r]);}
    asm volatile("s_waitcnt lgkmcnt(0)":::"memory");
    if(st_ok){
    #pragma unroll
    for(int i=0;i<4;++i){const int row=i*8+(lane>>3),ch=lane&7; const u32x4 v=*(const u32x4*)(stg+row*64+ch*8); const u32x4 g=gpre[i];
      const unsigned vv[4]={v.x,v.y,v.z,v.w},gg[4]={g.x,g.y,g.z,g.w}; unsigned ow[4];
      #pragma unroll
      for(int j=0;j<4;++j){ const float g0=__uint_as_float(gg[j]<<16),g1=__uint_as_float(gg[j]&0xffff0000u),o0=__uint_as_float(vv[j]<<16),o1=__uint_as_float(vv[j]&0xffff0000u);
        ow[j]=cvtpk_s(o0*__builtin_amdgcn_rcpf(1.f+__builtin_amdgcn_exp2f(-1.4426950408889634f*g0)),o1*__builtin_amdgcn_rcpf(1.f+__builtin_amdgcn_exp2f(-1.4426950408889634f*g1))); }
      ATTN_STORE16(Ow+(long)row*DM+ch*8,((u32x4){ow[0],ow[1],ow[2],ow[3]}));} } }
  asm volatile("s_waitcnt lgkmcnt(0)\n\ts_barrier":::"memory");
  #undef DMA_K
  #undef DMA_V
  #undef CMASK
  #undef START
  #undef RESC
  #undef ROT
}
constexpr int ATTN_LDS_BYTES=LDS_BYTES;
#undef SBAR
#undef WAIT_BAR
}
constexpr int NWAVES = 8;
constexpr int DM = 1024;
constexpr int PB = 16, PL = 2048, SBT = 32, SL = 64, PAST = 1024, SKV = PAST + SL;
constexpr int TP = PB * PL, TS = SBT * SL, T = TP + TS;
constexpr int DIN = 2048, CONVD = 3072, NH = 32, NST = 128;
constexpr int IN_DIM = 5152, IN_PAD = 5376, ZXLD = 5120;
constexpr int KVN = 2064, KVPAD = 2304;
constexpr int AH = 16;
constexpr int NEXP = 16384;
constexpr float LN_EPS = 1e-5f, RMS_EPS = 1e-5f;
constexpr float DN_ALPHA = 1.6817928305074290f;
constexpr float ATT_SCALE = 0.125f;

constexpr size_t O_Y = 0, O_PSSM = 35651584, O_PCONV = 44040192, O_PK = 44335104, O_PV = 77889536, O_PLOGF = 111443968,
                 O_SSSM = 111968256, O_SCONV = 128745472, O_SK = 129335296, O_SV = 131432448, O_SLOGF = 133529600, O_END = 133562368;

constexpr size_t MiB = 1u << 20;
constexpr size_t WS_CTL = 0, CTL_ZERO_BYTES = 1 * MiB;
constexpr size_t WS_WIN = 2 * MiB;
constexpr size_t WS_WOUT = 23 * MiB;
constexpr size_t WS_WKV = 31 * MiB;
constexpr size_t WS_WQG = 36 * MiB;
constexpr size_t WS_WO = 44 * MiB;
constexpr size_t WS_WPQ = 48 * MiB;
constexpr size_t WS_SKT = 64 * MiB;
constexpr size_t WS_XB = 66 * MiB;
constexpr size_t WS_R1 = 134 * MiB;
constexpr size_t WS_PQ = WS_R1, WS_QB = WS_R1, WS_GB = WS_R1 + 68 * MiB, WS_OG = WS_R1 + 136 * MiB;
constexpr size_t WS_PART = WS_R1;
constexpr size_t WS_HH = WS_R1 + 136 * MiB;
constexpr size_t WS_DT = 474 * MiB;
constexpr size_t WS_XC = 479 * MiB;
constexpr int SKVP = 1152;
constexpr size_t WS_KP = 479 * MiB, WS_VP = 543 * MiB, WS_KS = 607 * MiB, WS_VS = 679 * MiB, WS_LOGF = 751 * MiB, WS_BIASP = 754 * MiB, WS_BIASS = 757 * MiB, WS_KVEND = 760 * MiB;
constexpr size_t WS_IMG = WS_XC;
constexpr int SSD_IMG = 49152;
constexpr size_t WS_Y = 683 * MiB;
constexpr size_t WS_MIX = 819 * MiB;
constexpr size_t WS_XT = WS_MIX;
constexpr size_t WS_EIDX = 955 * MiB;
constexpr size_t WS_GATE = 972 * MiB;
constexpr size_t WS_T8 = 989 * MiB;
constexpr size_t WS_TSC = 1021 * MiB;
constexpr size_t WS_XQ = 1022 * MiB;
constexpr size_t WS_SX = 1056 * MiB;
constexpr size_t WS_T8B = 1057 * MiB;
constexpr size_t WS_TSCB = 1089 * MiB;
constexpr size_t WS_END = 1090 * MiB;
static_assert(WS_WIN + (size_t)2 * IN_PAD * 1024 * 2 <= WS_WOUT && WS_WKV + (size_t)KVPAD * 1024 * 2 <= WS_WQG && WS_XB + (size_t)T * 1024 * 2 <= WS_R1, "ws map 1");
static_assert(WS_R1 + (size_t)T * ZXLD * 2 <= WS_DT && WS_DT + (size_t)T * 32 * 4 <= WS_XC && WS_XC + (size_t)T * CONVD * 2 <= WS_Y && WS_Y + (size_t)T * DIN * 2 <= WS_MIX, "ws map 2");
static_assert(WS_MIX + (size_t)T * 1024 * 4 <= WS_EIDX && WS_EIDX + (size_t)T * 128 * 4 <= WS_GATE && WS_GATE + (size_t)T * 128 * 4 <= WS_T8, "ws map 3");
static_assert(WS_KS + (size_t)SBT * SKVP * 1024 * 2 <= WS_VS && WS_VS + (size_t)SBT * SKVP * 1024 * 2 <= WS_LOGF && WS_LOGF + (size_t)T * 16 * 4 <= WS_BIASP && WS_BIASP + (size_t)PB * AH * PL * 4 <= WS_BIASS && WS_BIASS + (size_t)SBT * AH * SKVP * 4 <= WS_KVEND && WS_KVEND <= 819 * MiB, "ws map 4");
constexpr int CW_TMO = 0, CW_CODE = 1, CW_BAR = 4096, MAX_BAR_REGIONS = 48;
constexpr int CW_HO = 1024, HO_STRIDE = 256, HO_ROWT = 32;
static_assert((CW_BAR + MAX_BAR_REGIONS * XCD_BAR_WORDS) * 4 <= (int)CTL_ZERO_BYTES, "CTL words inside the memset region");

constexpr int RING_OFF = 0, RING_BYTES = 131072;
constexpr int LDSCTL_OFF = RING_BYTES, MISC_OFF = LDSCTL_OFF + 320;
constexpr int LDS_BYTES = 147456;

#define DI __device__ __forceinline__
DI float bf2f(unsigned short u) { return __uint_as_float(((unsigned)u) << 16); }
DI float bflo(unsigned w) { return __uint_as_float(w << 16); }
DI float bfhi(unsigned w) { return __uint_as_float(w & 0xffff0000u); }
DI float silu_f(float v) { return v * __builtin_amdgcn_rcpf(1.f + __builtin_amdgcn_exp2f(-1.4426950408889634f * v)); }
DI float sigmoid_f(float v) { return __builtin_amdgcn_rcpf(1.f + __builtin_amdgcn_exp2f(-1.4426950408889634f * v)); }
DI float softplus_f(float v) { return v > 20.f ? v : log1pf(expf(v)); }
DI float logsigmoid_f(float v) { return v >= 0.f ? -log1pf(expf(-v)) : v - log1pf(expf(v)); }
DI float gelu_erf(float v) { return 0.5f * v * (1.f + erff(v * 0.70710678118654752f)); }
DI float dpp_xor1(float v) { return __builtin_bit_cast(float, __builtin_amdgcn_update_dpp(0, __builtin_bit_cast(int, v), 0xB1, 0xF, 0xF, true)); }
DI float dpp_xor2(float v) { return __builtin_bit_cast(float, __builtin_amdgcn_update_dpp(0, __builtin_bit_cast(int, v), 0x4E, 0xF, 0xF, true)); }
DI float swz_xor4(float v) { return __builtin_bit_cast(float, __builtin_amdgcn_ds_swizzle(__builtin_bit_cast(int, v), 0x101F)); }
DI float dpp_xor8(float v) { return __builtin_bit_cast(float, __builtin_amdgcn_update_dpp(0, __builtin_bit_cast(int, v), 0x128, 0xF, 0xF, true)); }
DI float swz_xor16(float v) { return __builtin_bit_cast(float, __builtin_amdgcn_ds_swizzle(__builtin_bit_cast(int, v), 0x401F)); }
DI float xor32(float v) { const auto r = __builtin_amdgcn_permlane32_swap(__float_as_uint(v), __float_as_uint(v), false, false); return __uint_as_float((threadIdx.x & 32) ? r[0] : r[1]); }
DI float wave_sum(float v) { v += dpp_xor1(v); v += dpp_xor2(v); v += swz_xor4(v); v += dpp_xor8(v); v += swz_xor16(v); v += xor32(v); return v; }
DI float wave_max(float v) { v = fmaxf(v, dpp_xor1(v)); v = fmaxf(v, dpp_xor2(v)); v = fmaxf(v, swz_xor4(v)); v = fmaxf(v, dpp_xor8(v)); v = fmaxf(v, swz_xor16(v)); v = fmaxf(v, xor32(v)); return v; }

#ifndef RP_GU
#define RP_GU 1
#endif
#ifndef RP_BAR
#define RP_BAR 1
#endif
#ifndef RP_LN
#define RP_LN 1
#endif
#ifndef RP_PRO
#define RP_PRO 1
#endif
#ifndef RP_KVP
#define RP_KVP 1
#endif
#ifndef RP_GC
#define RP_GC 1
#endif
#ifndef RP_CVT
#define RP_CVT 1
#endif
#ifndef RP_TOPK
#define RP_TOPK 1
#endif
#ifndef RP_GATHER
#define RP_GATHER 1
#endif
#ifndef RP_ATTN
#define RP_ATTN 1
#endif
#ifndef RP_SCAN
#define RP_SCAN 1
#endif
#ifndef RP_CONV
#define RP_CONV 1
#endif
#ifndef RP_GEMM
#define RP_GEMM 1
#endif
struct Ctx {
    LAS unsigned char* lds;
    int tid, lane, wave, vcu, G, bx;
};
struct Args { const float* in[25]; float* out; unsigned char* ws; int ph_lo, ph_hi, li, pad; };
typedef const __attribute__((address_space(4))) Args* CArgs;
DI Ctx mkctx(LAS unsigned char* lds) {
    Ctx c; int tid = threadIdx.x, G = gridDim.x, bx = blockIdx.x; asm volatile("" : "+v"(tid), "+s"(G), "+s"(bx));
    c.lds = lds; c.tid = tid; c.lane = tid & 63; c.wave = __builtin_amdgcn_readfirstlane(tid >> 6); c.G = G; c.vcu = (G % 8 == 0) ? (bx % 8) * (G / 8) + bx / 8 : bx; c.bx = bx;
    return c;
}
DI CArgs kargs() { CArgs p = (CArgs)__builtin_amdgcn_kernarg_segment_ptr(); asm volatile("" : "+s"(p)); return p; }

namespace pg8 {
struct EpiInproj {
    static constexpr bool PERM = true, AFTER_DRAIN = false;
    bf16_t* ZX; float* DT;
    __device__ __forceinline__ void operator()(const f32x4 (&acc)[2][2][4][2], const Unit& u, int wr, int wc, int fr, int fq) const {
        const int row0 = u.pm * BM + wr * 64 + fr;
        if (u.pn < 20) {
            const int col0 = u.pn * BM + wc * 32 + 8 * fq;
#pragma unroll
            for (int ai = 0; ai < 2; ++ai)
#pragma unroll
                for (int m = 0; m < 4; ++m) { bf16_t* rowp = ZX + (size_t)(row0 + ai * HALF + m * 16) * ZXLD + col0;
#pragma unroll
                    for (int bj = 0; bj < 2; ++bj) { const f32x4 v0 = acc[ai][bj][m][0], v1 = acc[ai][bj][m][1];
                        u32x4 w; w.x = cvt_pk_bf16(v0[0], v0[1]); w.y = cvt_pk_bf16(v0[2], v0[3]); w.z = cvt_pk_bf16(v1[0], v1[1]); w.w = cvt_pk_bf16(v1[2], v1[3]);
                        *(u32x4*)(rowp + bj * HALF) = w; } }
        } else if (wc == 0) {
#pragma unroll
            for (int ai = 0; ai < 2; ++ai)
#pragma unroll
                for (int m = 0; m < 4; ++m) { float* rp = DT + (size_t)(row0 + ai * HALF + m * 16) * 32 + 8 * fq;
                    *(f32x4*)rp = acc[ai][0][m][0]; *(f32x4*)(rp + 4) = acc[ai][0][m][1]; }
        }
    }
};
struct EpiKV {
    static constexpr bool PERM = true, AFTER_DRAIN = false;
    bf16_t* KP; bf16_t* VP; bf16_t* KS; bf16_t* VS; float* LOGF; float* out;
    __device__ __forceinline__ void operator()(const f32x4 (&acc)[2][2][4][2], const Unit& u, int wr, int wc, int fr, int fq) const {
        const int row0 = u.pm * BM + wr * 64 + fr;
        const bool prompt = (u.pm * BM) < TP;
        if (u.pn < 8) {
            const bool isv = u.pn >= 4;
            const int colb = (u.pn & 3) * BM + wc * 32 + 8 * fq;
            const size_t np = prompt ? 0u : 1u, iv = isv ? 1u : 0u;
            bf16_t* bb = (bf16_t*)((unsigned char*)KP + np * (WS_KS - WS_KP) + iv * (prompt ? (WS_VP - WS_KP) : (WS_VS - WS_KS)));
            float* fb = out + O_PK + np * (O_SK - O_PK) + iv * (prompt ? (O_PV - O_PK) : (O_SV - O_SK));
#pragma unroll
            for (int ai = 0; ai < 2; ++ai)
#pragma unroll
                for (int m = 0; m < 4; ++m) { const int row = row0 + ai * HALF + m * 16; const int orow = prompt ? row : row - TP;
#pragma unroll
                    for (int bj = 0; bj < 2; ++bj) { const f32x4 v0 = acc[ai][bj][m][0], v1 = acc[ai][bj][m][1]; const int col = colb + bj * HALF;
                        u32x4 w; w.x = cvt_pk_bf16(v0[0], v0[1]); w.y = cvt_pk_bf16(v0[2], v0[3]); w.z = cvt_pk_bf16(v1[0], v1[1]); w.w = cvt_pk_bf16(v1[2], v1[3]);
                        const size_t brow = prompt ? (size_t)row : (size_t)((orow >> 6) * SKVP + PAST + (orow & 63));
                        *(u32x4*)(bb + brow * 1024 + col) = w;
                        float* fp = fb + (size_t)orow * 1024 + col; *(f32x4*)fp = v0; *(f32x4*)(fp + 4) = v1; } }
        } else if (wc == 0 && fq < 2) {
#pragma unroll
            for (int ai = 0; ai < 2; ++ai)
#pragma unroll
                for (int m = 0; m < 4; ++m) { const int row = row0 + ai * HALF + m * 16;
                    *(f32x4*)(LOGF + (size_t)row * 16 + 8 * fq) = acc[ai][0][m][0]; *(f32x4*)(LOGF + (size_t)row * 16 + 8 * fq + 4) = acc[ai][0][m][1]; }
        }
    }
};
}

DI void p0_transpose_item(const float* W, int K, int ld, int Nvalid, int Npad, bf16* WT, LAS float* scr, int item, int lane) {
    const int nblk = Npad / 32, kb = item / nblk, nb = item % nblk, k0 = 64 * kb, n0 = 32 * nb;
    const int n4 = n0 + 4 * (lane & 7);
#pragma unroll
    for (int i = 0; i < 8; ++i) { const int kk = 8 * i + (lane >> 3); f32x4 v = (f32x4){0.f, 0.f, 0.f, 0.f};
        if (n4 + 3 < Nvalid) v = *(const f32x4*)(W + (size_t)(k0 + kk) * ld + n4);
        else { if (n4 < Nvalid) v.x = W[(size_t)(k0 + kk) * ld + n4]; if (n4 + 1 < Nvalid) v.y = W[(size_t)(k0 + kk) * ld + n4 + 1]; if (n4 + 2 < Nvalid) v.z = W[(size_t)(k0 + kk) * ld + n4 + 2]; }
        LAS float* d = scr + kk * 33 + 4 * (lane & 7); d[0] = v.x; d[1] = v.y; d[2] = v.z; d[3] = v.w; }
    LDS_WAIT(); asm volatile("" ::: "memory");
    const int c = lane & 7;
#pragma unroll
    for (int j = 0; j < 4; ++j) { const int n = (lane >> 3) + 8 * j; const LAS float* s = scr + (8 * c) * 33 + n;
        v4u o; o.x = pk2(s[0 * 33], s[1 * 33]); o.y = pk2(s[2 * 33], s[3 * 33]); o.z = pk2(s[4 * 33], s[5 * 33]); o.w = pk2(s[6 * 33], s[7 * 33]);
        *(GAS v4u*)(WT + (size_t)(n0 + n) * K + k0 + 8 * c) = o; }
    LDS_WAIT(); asm volatile("" ::: "memory");
}

struct TrJob { const float* W; int K, ld, Nvalid, Npad; bf16* WT; };

DI void weight_jobs(const Ctx& c, CArgs a, int set, int gw, int NGW) {
    LAS float* scr = (LAS float*)(c.lds + RING_OFF + c.wave * 16384);
    bf16* win = (bf16*)(a->ws + WS_WIN); bf16* wout = (bf16*)(a->ws + WS_WOUT); bf16* wkv = (bf16*)(a->ws + WS_WKV);
    bf16* wqg = (bf16*)(a->ws + WS_WQG); bf16* wo = (bf16*)(a->ws + WS_WO); bf16* wpq = (bf16*)(a->ws + WS_WPQ);
#define TRJOB(Wp, K_, ld_, Nv_, Np_, WTp) do { const int nit = ((K_) / 64) * ((Np_) / 32); for (int it = gw; it < nit; it += NGW) p0_transpose_item((Wp), (K_), (ld_), (Nv_), (Np_), (WTp), scr, it, c.lane); } while (0)
    if (set == 0) {
        TRJOB(a->in[7], 1024, IN_DIM, IN_DIM, IN_PAD, win);
        TRJOB(a->in[14], 2048, 1024, 1024, 1024, wout);
        TRJOB(a->in[19], 1024, 2048, 2048, 2048, wpq);
    } else {
        TRJOB(a->in[7] + (size_t)1024 * IN_DIM, 1024, IN_DIM, IN_DIM, IN_PAD, win + (size_t)IN_PAD * 1024);
        TRJOB(a->in[14] + (size_t)2048 * 1024, 2048, 1024, 1024, 1024, wout + (size_t)1024 * 2048);
        for (int l = 0; l < 2; ++l) {
            TRJOB(a->in[17] + (size_t)l * 1024 * 2048, 1024, 2048, 2048, 2048, wqg + (size_t)l * 2048 * 1024);
            TRJOB(a->in[18] + (size_t)l * 1024 * 1024, 1024, 1024, 1024, 1024, wo + (size_t)l * 1024 * 1024);
        }
        TRJOB(a->in[15], 1024, KVN, KVN, KVPAD, wkv);
        for (int l = 1; l < 4; ++l) TRJOB(a->in[19] + (size_t)l * 1024 * 2048, 1024, 2048, 2048, 2048, wpq + (size_t)l * 2048 * 1024);
    }
#undef TRJOB
}
DI void ph_prologue(const Ctx& c, CArgs a) {
    const int gw = c.vcu * NWAVES + c.wave, NGW = c.G * NWAVES;
    weight_jobs(c, a, 0, gw, NGW);
    { unsigned* ska = (unsigned*)(a->ws + WS_SKT); const float* sk = a->in[20];
      const int gt = (c.vcu * NWAVES + c.wave) * 64 + c.lane, NT = c.G * NWAVES * 64;
      for (int i = gt; i < 4 * 16384; i += NT) { const int e2 = i & 3, ln = (i >> 2) & 63, ks = (i >> 8) & 7, j = (i >> 11) & 3, lk = i >> 13;
          const int n = 32 * j + (ln & 31), d = 16 * ks + 8 * (ln >> 5) + 2 * e2;
          ska[i] = pk2(sk[((size_t)lk * 128 + n) * 128 + d], sk[((size_t)lk * 128 + n) * 128 + d + 1]); } }
    { bf16* xb = (bf16*)(a->ws + WS_XB);
      for (int m = gw; m < T; m += NGW) {
          const float* src = m < TP ? a->in[0] + (size_t)m * DM : a->in[1] + (size_t)(m - TP) * DM;
          const GAS f32x4* xr = (const GAS f32x4*)src + c.lane;
          GAS unsigned long long* o8 = (GAS unsigned long long*)(xb + (size_t)m * DM) + c.lane;
#pragma unroll
          for (int j = 0; j < 4; ++j) { const f32x4 v = xr[64 * j]; o8[64 * j] = (unsigned long long)pk2(v.x, v.y) | ((unsigned long long)pk2(v.z, v.w) << 32); } } }
}

constexpr int NCHUNK = T / 64;
DI void ph_ssdprep(const Ctx& c, CArgs a, int layer) {
    const bf16* ZX = (const bf16*)(a->ws + WS_R1); bf16* XT = (bf16*)(a->ws + WS_XT); unsigned char* IMG = a->ws + WS_IMG;
    const float* cw = a->in[8] + (size_t)layer * 4 * CONVD; const float* cb = a->in[9] + (size_t)layer * CONVD; const float* cst = a->in[3] + (size_t)layer * SBT * 3 * CONVD;
    LAS unsigned short* raw = (LAS unsigned short*)(c.lds + RING_OFF + c.wave * 8704);
    const int gw = c.vcu * NWAVES + c.wave, NGW = c.G * NWAVES, lane = c.lane;
    for (int task = gw; task < NCHUNK * 48; task += NGW) {
        const int ck = task / 48, ct = task % 48, t0 = ck * 64, ch0 = ct * 64;
        const bool sample = ck >= PB * (PL / 64); const bool first = sample || (ck % (PL / 64)) == 0; const int sb = ck - PB * (PL / 64);
#pragma unroll
        for (int i = 0; i < 9; ++i) { const int row = i * 8 + (lane >> 3) - 3, col8 = (lane & 7) * 8;
            if (row < 64) { v4u w;
                if (row >= 0 || !first) w = *(const v4u*)(ZX + (size_t)(t0 + row) * ZXLD + 2048 + ch0 + col8);
                else if (sample) { const float* sp = cst + ((size_t)sb * 3 + (row + 3)) * CONVD + ch0 + col8; const f32x4 s0 = *(const f32x4*)sp, s1 = *(const f32x4*)(sp + 4);
                    w = (v4u){pk2(s0.x, s0.y), pk2(s0.z, s0.w), pk2(s1.x, s1.y), pk2(s1.z, s1.w)}; }
                else w = (v4u){0u, 0u, 0u, 0u};
                *(LAS v4u*)(raw + (row + 3) * 64 + col8) = w; } }
        LDS_WAIT(); asm volatile("" ::: "memory");
        const int ch = ch0 + lane;
        const float w0 = cw[ch], w1 = cw[CONVD + ch], w2 = cw[2 * CONVD + ch], w3 = cw[3 * CONVD + ch], bs = cb[ch];
        float u0 = bf2f(raw[0 * 64 + lane]), u1 = bf2f(raw[1 * 64 + lane]), u2 = bf2f(raw[2 * 64 + lane]);
        unsigned op[32];
#pragma unroll
        for (int s2 = 0; s2 < 32; ++s2) {
            const float ua = bf2f(raw[(2 * s2 + 3) * 64 + lane]), ub = bf2f(raw[(2 * s2 + 4) * 64 + lane]);
            const float va = silu_f(bs + w0 * u0 + w1 * u1 + w2 * u2 + w3 * ua), vb = silu_f(bs + w0 * u1 + w1 * u2 + w2 * ua + w3 * ub);
            op[s2] = pk2(va, vb); u0 = u2; u1 = ua; u2 = ub; }
        LDS_WAIT(); asm volatile("" ::: "memory");
        if (ct < 32) {
            bf16* dst = XT + (((size_t)ck * NH + ct) * 64 + lane) * 64;
#pragma unroll
            for (int q = 0; q < 8; ++q) *(v4u*)(dst + 8 * q) = (v4u){op[4 * q], op[4 * q + 1], op[4 * q + 2], op[4 * q + 3]};
        } else {
            const int cb = ct - 32, isc = cb >> 3, g = (cb & 7) >> 1, nh = cb & 1;
            unsigned char* img = IMG + ((size_t)ck * 4 + g) * SSD_IMG;
            if (!isc) {
#pragma unroll
                for (int q = 0; q < 8; ++q) *(v4u*)(img + 32768 + q * 2048 + (64 * nh + lane) * 16) = (v4u){op[4 * q], op[4 * q + 1], op[4 * q + 2], op[4 * q + 3]}; }
#pragma unroll
            for (int s2 = 0; s2 < 32; ++s2) { raw[(2 * s2) * 64 + lane] = (unsigned short)(op[s2] & 0xffffu); raw[(2 * s2 + 1) * 64 + lane] = (unsigned short)(op[s2] >> 16); }
            LDS_WAIT(); asm volatile("" ::: "memory");
#pragma unroll
            for (int i = 0; i < 8; ++i) *(v4u*)(img + isc * 16384 + (8 * nh + i) * 1024 + lane * 16) = *(const LAS v4u*)(raw + lane * 64 + 8 * i);
            LDS_WAIT(); asm volatile("" ::: "memory");
        }
    }
    { const int gt = gw * 64 + lane, NT = NGW * 64;
      for (int idx = gt; idx < (PB + SBT) * 3 * CONVD; idx += NT) {
          const int ch = idx % CONVD, r = (idx / CONVD) % 3, sq = idx / (3 * CONVD);
          if (sq < PB) { const int row = sq * PL + PL - 3 + r; a->out[O_PCONV + (((size_t)layer * PB + sq) * 3 + r) * CONVD + ch] = bf2f(ZX[(size_t)row * ZXLD + 2048 + ch]); }
          else { const int b = sq - PB; const int row = TP + b * SL + SL - 3 + r; a->out[O_SCONV + (((size_t)layer * SBT + b) * 3 + r) * CONVD + ch] = bf2f(ZX[(size_t)row * ZXLD + 2048 + ch]); } } }
}

typedef float f32x16v __attribute__((ext_vector_type(16)));
typedef unsigned u32x2v __attribute__((ext_vector_type(2)));
DI int crow16(int r, int hi) { return (r & 3) + 8 * (r >> 2) + 4 * hi; }
DI bf16x8 pack8(float v0, float v1, float v2, float v3, float v4, float v5, float v6, float v7) { v4u w; w.x = pg8::cvt_pk_bf16(v0, v1); w.y = pg8::cvt_pk_bf16(v2, v3); w.z = pg8::cvt_pk_bf16(v4, v5); w.w = pg8::cvt_pk_bf16(v6, v7); return __builtin_bit_cast(bf16x8, w); }
DI bf16x8 ld2x8(const bf16* p) { const u32x2v lo = *(const u32x2v*)p, hi2 = *(const u32x2v*)(p + 8); return __builtin_bit_cast(bf16x8, (v4u){lo.x, lo.y, hi2.x, hi2.y}); }
#define SSD_MFMA(A_, B_, C_) __builtin_amdgcn_mfma_f32_32x32x16_bf16((A_), (B_), (C_), 0, 0, 0)
constexpr int SSD_BUF = 49152, SSD_VEC = 2 * SSD_BUF;
DI void ssd_wg_unit(const Ctx& c, CArgs a, int layer, bool sample, int b, int g, int hq) {
    const bf16* XT = (const bf16*)(a->ws + WS_XT); const char* IMGg = (const char*)(a->ws + WS_IMG);
    const float* DT = (const float*)(a->ws + WS_DT); bf16* Y = (bf16*)(a->ws + WS_Y);
    const int lane = c.lane, r32 = lane & 31, hi = lane >> 5, wave = c.wave, head = g * 8 + hq * 4 + (wave >> 1), ph = wave & 1;
    const int row0 = sample ? TP + b * SL : b * PL, nchunk = sample ? 1 : PL / 64, ck0 = row0 / 64;
    const float Ah = -expf(a->in[11][layer * NH + head]), dtb = a->in[10][layer * NH + head], Dh = a->in[12][layer * NH + head];
    LAS float* lv = (LAS float*)(c.lds + RING_OFF + SSD_VEC + wave * 1024);
    LAS float* Ldt = lv; LAS float* Lacs = lv + 64; LAS float* Lw2 = lv + 128; LAS float* Le = lv + 192;
    const unsigned ldsb = (unsigned)(size_t)(c.lds + RING_OFF);
#define SSD_DMA(t0_, ck_, bsel_) do { const char* ib_ = IMGg + ((size_t)(ck_) * 4 + g) * SSD_IMG + lane * 16; \
        _Pragma("unroll") for (int pc_ = 0; pc_ < 6; ++pc_) { const int P_ = wave + 8 * (pc_ & 1); \
            const unsigned dst_ = (pc_ < 4) ? (pc_ >> 1) * 16384 + P_ * 1024 : 32768 + (P_ & 7) * 2048 + (P_ >> 3) * 1024;        \
            attn_body::glds16(ib_ + dst_, (unsigned)__builtin_amdgcn_readfirstlane(ldsb + (bsel_) * SSD_BUF + dst_)); } } while (0)
    f32x16v H[4];
    if (sample) { const float* sp = a->in[2] + (((size_t)layer * SBT + b) * NH + head) * 8192 + (size_t)(32 * ph + r32) * 128;
#pragma unroll
        for (int nt = 0; nt < 4; ++nt)
#pragma unroll
            for (int q = 0; q < 4; ++q) { const f32x4 v = *(const f32x4*)(sp + 32 * nt + 8 * q + 4 * hi); H[nt][4 * q] = v.x; H[nt][4 * q + 1] = v.y; H[nt][4 * q + 2] = v.z; H[nt][4 * q + 3] = v.w; } }
    else {
#pragma unroll
        for (int nt = 0; nt < 4; ++nt) H[nt] = f32x16v{}; }
    bf16x8 XFn[2][2]; float dtn;
#define SSD_LDX(ck_, t0_) do { const bf16* xtp_ = XT + (((size_t)(ck_) * NH + head) * 64 + 32 * ph + r32) * 64; \
        _Pragma("unroll") for (int st = 0; st < 2; ++st) _Pragma("unroll") for (int sp = 0; sp < 2; ++sp) XFn[st][sp] = ld2x8(xtp_ + 32 * st + 16 * sp + 4 * hi); \
        dtn = DT[(size_t)((t0_) + lane) * 32 + head]; } while (0)
    asm volatile("s_waitcnt vmcnt(0) lgkmcnt(0)\n\ts_barrier" ::: "memory");
    SSD_DMA(row0, ck0, 0); SSD_LDX(ck0, row0);
    asm volatile("s_waitcnt vmcnt(0)" ::: "memory");
    for (int ci = 0; ci < nchunk; ++ci) {
        const int t0 = row0 + ci * 64;
        asm volatile("s_waitcnt vmcnt(24) lgkmcnt(0)\n\ts_barrier" ::: "memory");
        asm volatile("" : "+v"(XFn[0][0]), "+v"(XFn[0][1]), "+v"(XFn[1][0]), "+v"(XFn[1][1]), "+v"(dtn));
        bf16x8 XF[2][2];
#pragma unroll
        for (int st = 0; st < 2; ++st)
#pragma unroll
            for (int sp = 0; sp < 2; ++sp) XF[st][sp] = XFn[st][sp];
        const float dtraw = dtn;
        if (ci + 1 < nchunk) { SSD_DMA(t0 + 64, ck0 + ci + 1, (ci + 1) & 1); SSD_LDX(ck0 + ci + 1, t0 + 64); }
        LAS const char* Bs = (LAS const char*)(c.lds + RING_OFF + (ci & 1) * SSD_BUF); LAS const char* Cs = Bs + 16384; LAS const char* BTs = Bs + 32768;
        const int lb16 = hi * 1024 + r32 * 16, lb8 = r32 * 16 + 8 * hi;
        float tot;
        { const float vv = dtraw + dtb, ev = __builtin_amdgcn_exp2f(vv * 1.4426950408889634f);
          const float dtv = vv > 15.f ? vv : (vv < -6.f ? ev - 0.5f * ev * ev : __builtin_amdgcn_logf(1.f + ev) * 0.6931471805599453f);
          float acs = dtv * (Ah * 1.4426950408889634f);
#pragma unroll
          for (int o = 1; o < 64; o <<= 1) { const float v = __shfl_up(acs, o); if (lane >= o) acs += v; }
          tot = __shfl(acs, 63);
          Ldt[lane] = dtv; Lacs[lane] = acs; Lw2[lane] = dtv * __builtin_amdgcn_exp2f(tot - acs); Le[lane] = __builtin_amdgcn_exp2f(acs); }
        LDS_WAIT(); asm volatile("" ::: "memory");
        bf16x8 MA00[2], MA01[2], MA11[2];
        { const float al0 = Lacs[r32], al1 = Lacs[32 + r32];
#define SSD_ST(MA_, sto_, lto_, al_, MASK_) do { f32x16v ST_ = f32x16v{}; \
            _Pragma("unroll") for (int ks = 0; ks < 8; ++ks) ST_ = SSD_MFMA(*(LAS const bf16x8*)(Bs + lb16 + ks * 2048 + (sto_) * 16), *(LAS const bf16x8*)(Cs + lb16 + ks * 2048 + (lto_) * 16), ST_); \
            float m_[16]; \
            _Pragma("unroll") for (int q = 0; q < 4; ++q) { const f32x4 xa = *(const LAS f32x4*)(Lacs + (sto_) + 8 * q + 4 * hi), xd = *(const LAS f32x4*)(Ldt + (sto_) + 8 * q + 4 * hi); \
                _Pragma("unroll") for (int i = 0; i < 4; ++i) { const int r = 4 * q + i; const float v = ST_[r] * __builtin_amdgcn_exp2f((al_) - xa[i]) * xd[i]; m_[r] = ((MASK_) && crow16(r, hi) > r32) ? 0.f : v; } } \
            MA_[0] = pack8(m_[0], m_[1], m_[2], m_[3], m_[4], m_[5], m_[6], m_[7]); MA_[1] = pack8(m_[8], m_[9], m_[10], m_[11], m_[12], m_[13], m_[14], m_[15]); } while (0)
          SSD_ST(MA00, 0, 0, al0, true); SSD_ST(MA01, 0, 32, al1, false); SSD_ST(MA11, 32, 32, al1, true);
#undef SSD_ST
        }
        f32x16v Y0 = f32x16v{}, Y1 = f32x16v{};
#pragma unroll
        for (int nt = 0; nt < 4; ++nt)
#pragma unroll
            for (int st = 0; st < 2; ++st) { const bf16x8 hb = pack8(H[nt][8 * st], H[nt][8 * st + 1], H[nt][8 * st + 2], H[nt][8 * st + 3], H[nt][8 * st + 4], H[nt][8 * st + 5], H[nt][8 * st + 6], H[nt][8 * st + 7]);
                const int c1 = 4 * nt + 2 * st;
                const u32x2v p0 = *(LAS const u32x2v*)(Cs + lb8 + c1 * 1024), p1 = *(LAS const u32x2v*)(Cs + lb8 + (c1 + 1) * 1024), p2 = *(LAS const u32x2v*)(Cs + lb8 + c1 * 1024 + 512), p3 = *(LAS const u32x2v*)(Cs + lb8 + (c1 + 1) * 1024 + 512);
                Y0 = SSD_MFMA(__builtin_bit_cast(bf16x8, (v4u){p0.x, p0.y, p1.x, p1.y}), hb, Y0); Y1 = SSD_MFMA(__builtin_bit_cast(bf16x8, (v4u){p2.x, p2.y, p3.x, p3.y}), hb, Y1); }
#pragma unroll
        for (int q = 0; q < 4; ++q) { const f32x4 e0 = *(const LAS f32x4*)(Le + 8 * q + 4 * hi), e1 = *(const LAS f32x4*)(Le + 32 + 8 * q + 4 * hi);
#pragma unroll
            for (int i = 0; i < 4; ++i) { Y0[4 * q + i] *= e0[i]; Y1[4 * q + i] *= e1[i]; } }
#pragma unroll
        for (int sp = 0; sp < 2; ++sp) { Y0 = SSD_MFMA(MA00[sp], XF[0][sp], Y0); Y1 = SSD_MFMA(MA01[sp], XF[0][sp], Y1); Y1 = SSD_MFMA(MA11[sp], XF[1][sp], Y1); }
#pragma unroll
        for (int sp = 0; sp < 2; ++sp) { const v4u w0 = __builtin_bit_cast(v4u, XF[0][sp]), w1 = __builtin_bit_cast(v4u, XF[1][sp]); const unsigned ww0[4] = {w0.x, w0.y, w0.z, w0.w}, ww1[4] = {w1.x, w1.y, w1.z, w1.w};
#pragma unroll
            for (int i = 0; i < 4; ++i) { Y0[8 * sp + 2 * i] += Dh * bflo(ww0[i]); Y0[8 * sp + 2 * i + 1] += Dh * bfhi(ww0[i]); Y1[8 * sp + 2 * i] += Dh * bflo(ww1[i]); Y1[8 * sp + 2 * i + 1] += Dh * bfhi(ww1[i]); } }
        { bf16* yb = Y + (size_t)t0 * DIN + head * 64 + 32 * ph;
          int lo_ = r32 + 4 * hi * DIN; asm volatile("" : "+v"(lo_));
#pragma unroll
          for (int r = 0; r < 16; r += 2) { const unsigned w0 = pg8::cvt_pk_bf16(Y0[r], Y0[r + 1]), w1 = pg8::cvt_pk_bf16(Y1[r], Y1[r + 1]);
              const int o0 = lo_ + ((r & 3) + 8 * (r >> 2)) * DIN, o1 = lo_ + (((r + 1) & 3) + 8 * ((r + 1) >> 2)) * DIN;
              yb[o0] = (bf16)(w0 & 0xffffu); yb[o1] = (bf16)(w0 >> 16); yb[o0 + 32 * DIN] = (bf16)(w1 & 0xffffu); yb[o1 + 32 * DIN] = (bf16)(w1 >> 16); } }
        { const float dec = __builtin_amdgcn_exp2f(tot);
#pragma unroll
          for (int nt = 0; nt < 4; ++nt) H[nt] = H[nt] * dec;
#pragma unroll
          for (int st = 0; st < 2; ++st)
#pragma unroll
              for (int sp = 0; sp < 2; ++sp) {
                  const int s0 = 32 * st + 16 * sp + 4 * hi; const v4u xw = __builtin_bit_cast(v4u, XF[st][sp]); const f32x4 wa = *(const LAS f32x4*)(Lw2 + s0), wb = *(const LAS f32x4*)(Lw2 + s0 + 8);
                  const bf16x8 x2 = pack8(bflo(xw.x) * wa.x, bfhi(xw.x) * wa.y, bflo(xw.y) * wa.z, bfhi(xw.y) * wa.w, bflo(xw.z) * wb.x, bfhi(xw.z) * wb.y, bflo(xw.w) * wb.z, bfhi(xw.w) * wb.w);
                  const int cb = 4 * st + 2 * sp;
#pragma unroll
                  for (int nt = 0; nt < 4; ++nt) {
                      const u32x2v p0 = *(LAS const u32x2v*)(BTs + lb8 + cb * 2048 + nt * 512), p1 = *(LAS const u32x2v*)(BTs + lb8 + (cb + 1) * 2048 + nt * 512);
                      H[nt] = SSD_MFMA(__builtin_bit_cast(bf16x8, (v4u){p0.x, p0.y, p1.x, p1.y}), x2, H[nt]); } } }
    }
#undef SSD_DMA
#undef SSD_LDX
    { float* op = a->out + (sample ? O_SSSM + (((size_t)layer * SBT + b) * NH + head) * 8192 : O_PSSM + (((size_t)layer * PB + b) * NH + head) * 8192) + (size_t)(32 * ph + r32) * 128;
#pragma unroll
      for (int nt = 0; nt < 4; ++nt)
#pragma unroll
          for (int q = 0; q < 4; ++q) *(f32x4*)(op + 32 * nt + 8 * q + 4 * hi) = (f32x4){H[nt][4 * q], H[nt][4 * q + 1], H[nt][4 * q + 2], H[nt][4 * q + 3]}; }
}
DI void ph_tblcvt(const Ctx& c, CArgs a, int layer, int gw, int NGW, int row_lo = 0, int row_hi = 2 * NEXP);
DI void ph_scan(const Ctx& c, CArgs a, int layer) {
    for (int e = c.bx; e < 256; e += c.G) {
        const bool sample = (e & 1) != 0; const int nrep = sample ? 2 : 1;
        for (int k = 0; k < nrep; ++k) { const int u = sample ? (e >> 1) * 2 + k : (e >> 1); ssd_wg_unit(c, a, layer, sample, u >> 3, (u >> 1) & 3, u & 1); }
    }
    asm volatile("s_waitcnt vmcnt(0) lgkmcnt(0)\n\ts_barrier" ::: "memory");
    { const bool helper = (c.G >= 2) ? (c.bx & 1) != 0 : true; const int hw = ((c.G >= 2) ? (c.bx >> 1) : 0) * NWAVES + c.wave, nhw = ((c.G >= 2) ? (c.G >> 1) : 1) * NWAVES;
      if (helper) { if (layer == 0) weight_jobs(c, a, 1, hw, nhw); ph_tblcvt(c, a, layer, hw, nhw); if (layer == 1) ph_tblcvt(c, a, 2, hw, nhw); } }
}

DI void ph_gnorm(const Ctx& c, CArgs a, int layer) {
    const bf16* ZX = (const bf16*)(a->ws + WS_R1); bf16* Y = (bf16*)(a->ws + WS_Y); const float* nw = a->in[13] + (size_t)layer * DIN;
    const int gw = c.vcu * NWAVES + c.wave, NGW = c.G * NWAVES, ch0 = c.lane * 32;
    for (int m = gw; m < T; m += NGW) {
        float hv[32]; float ss = 0.f;
#pragma unroll
        for (int q = 0; q < 4; ++q) { const v4u wy = *(const v4u*)(Y + (size_t)m * DIN + ch0 + 8 * q), wz = *(const v4u*)(ZX + (size_t)m * ZXLD + ch0 + 8 * q);
            const unsigned yy[4] = {wy.x, wy.y, wy.z, wy.w}, zz[4] = {wz.x, wz.y, wz.z, wz.w};
#pragma unroll
            for (int i = 0; i < 4; ++i) { const float a = bflo(yy[i]) * silu_f(bflo(zz[i])), b = bfhi(yy[i]) * silu_f(bfhi(zz[i])); hv[8 * q + 2 * i] = a; hv[8 * q + 2 * i + 1] = b; ss += a * a + b * b; } }
        ss += dpp_xor1(ss); ss += dpp_xor2(ss); ss += swz_xor4(ss); ss += dpp_xor8(ss);
        const float rstd = 1.f / sqrtf(ss * (1.f / 512.f) + RMS_EPS);
#pragma unroll
        for (int q = 0; q < 4; ++q) { const f32x4 w0 = *(const f32x4*)(nw + ch0 + 8 * q), w1 = *(const f32x4*)(nw + ch0 + 8 * q + 4);
            v4u o; o.x = pk2(hv[8 * q] * rstd * w0.x, hv[8 * q + 1] * rstd * w0.y); o.y = pk2(hv[8 * q + 2] * rstd * w0.z, hv[8 * q + 3] * rstd * w0.w);
            o.z = pk2(hv[8 * q + 4] * rstd * w1.x, hv[8 * q + 5] * rstd * w1.y); o.w = pk2(hv[8 * q + 6] * rstd * w1.z, hv[8 * q + 7] * rstd * w1.w);
            *(v4u*)(Y + (size_t)m * DIN + ch0 + 8 * q) = o; }
    }
}

template <int NR> DI void ln_rows(const Ctx& c, CArgs a, const int (&m)[NR], const bool (&ok)[NR], const bf16* R, const bf16* xin, bf16* xb, const float* g, const float* be, bool last, bool quant) {
    unsigned long long xw[NR][4], rw[NR][4];
#pragma unroll
    for (int k = 0; k < NR; ++k) { const GAS unsigned long long* xr = (const GAS unsigned long long*)(xin + (size_t)m[k] * DM) + c.lane; const GAS unsigned long long* rr = (const GAS unsigned long long*)(R + (size_t)m[k] * DM) + c.lane;
#pragma unroll
        for (int j = 0; j < 4; ++j) { xw[k][j] = ok[k] ? xr[64 * j] : 0ull; rw[k][j] = ok[k] ? rr[64 * j] : 0ull; } }
    f32x4 gg[4], bb[4];
#pragma unroll
    for (int j = 0; j < 4; ++j) { gg[j] = *((const f32x4*)g + 64 * j + c.lane); bb[j] = *((const f32x4*)be + 64 * j + c.lane); }
    f32x4 v[NR][4]; float s[NR], s2[NR];
#pragma unroll
    for (int k = 0; k < NR; ++k) { s[k] = 0.f;
#pragma unroll
        for (int j = 0; j < 4; ++j) { const unsigned long long x_ = xw[k][j], r_ = rw[k][j];
            const f32x4 xv = (f32x4){bflo((unsigned)x_), bfhi((unsigned)x_), bflo((unsigned)(x_ >> 32)), bfhi((unsigned)(x_ >> 32))}, rv = (f32x4){bflo((unsigned)r_), bfhi((unsigned)r_), bflo((unsigned)(r_ >> 32)), bfhi((unsigned)(r_ >> 32))};
            v[k][j] = xv * DN_ALPHA + rv; s[k] += (v[k][j].x + v[k][j].y) + (v[k][j].z + v[k][j].w); } }
#pragma unroll
    for (int k = 0; k < NR; ++k) { const float mean = wave_sum(s[k]) * (1.f / DM); s2[k] = 0.f;
#pragma unroll
        for (int j = 0; j < 4; ++j) { v[k][j] = v[k][j] - mean; s2[k] += (v[k][j].x * v[k][j].x + v[k][j].y * v[k][j].y) + (v[k][j].z * v[k][j].z + v[k][j].w * v[k][j].w); } }
#pragma unroll
    for (int k = 0; k < NR; ++k) {
        const float rstd = 1.f / sqrtf(wave_sum(s2[k]) * (1.f / DM) + LN_EPS);
        GAS unsigned long long* o8 = (GAS unsigned long long*)(xb + (size_t)m[k] * DM) + c.lane; GAS f32x4* of = (GAS f32x4*)(a->out + O_Y + (size_t)m[k] * DM) + c.lane;
#pragma unroll
        for (int j = 0; j < 4; ++j) { const f32x4 o = v[k][j] * rstd * gg[j] + bb[j]; v[k][j] = o;
            if (ok[k]) { if (last) of[64 * j] = o; else o8[64 * j] = (unsigned long long)pk2(o.x, o.y) | ((unsigned long long)pk2(o.z, o.w) << 32); } }
        if (quant) {
            float am = 0.f;
#pragma unroll
            for (int j = 0; j < 4; ++j) am = fmaxf(am, fmaxf(fmaxf(fabsf(v[k][j].x), fabsf(v[k][j].y)), fmaxf(fabsf(v[k][j].z), fabsf(v[k][j].w))));
            am = wave_max(am); const float sc = am > 0.f ? 127.f / am : 1.f;
            unsigned* xq = (unsigned*)(a->ws + WS_XQ) + (size_t)m[k] * (DM / 4) + c.lane;
            if (ok[k]) {
#pragma unroll
                for (int j = 0; j < 4; ++j) { const int q0 = __float2int_rn(v[k][j].x * sc), q1 = __float2int_rn(v[k][j].y * sc), q2 = __float2int_rn(v[k][j].z * sc), q3 = __float2int_rn(v[k][j].w * sc);
                    xq[64 * j] = (unsigned)(q0 & 0xff) | ((unsigned)(q1 & 0xff) << 8) | ((unsigned)(q2 & 0xff) << 16) | ((unsigned)(q3 & 0xff) << 24); }
                if (c.lane == 0) ((float*)(a->ws + WS_SX))[m[k]] = am > 0.f ? am * (1.f / 127.f) : 1.f;
            }
        }
    }
}
#ifndef LN_NR
#define LN_NR 4
#endif
DI void ph_ln(const Ctx& c, CArgs a, int layer, int which, bool dry = false) {
    const bf16* R = (const bf16*)(a->ws + WS_MIX); const bf16* xin = (const bf16*)(a->ws + WS_XB); bf16* xb = (bf16*)(a->ws + (dry ? WS_R1 + 160 * MiB : WS_XB));
    const bool last = (layer == 3 && which == 1 && !dry);
    const float* g = a->in[23] + ((size_t)layer * 2 + which) * DM; const float* be = a->in[24] + ((size_t)layer * 2 + which) * DM;
    const int gw = c.vcu * NWAVES + c.wave, NGW = c.G * NWAVES;
    for (int m0 = gw; m0 < T; m0 += LN_NR * NGW) {
        int m[LN_NR]; bool ok[LN_NR];
#pragma unroll
        for (int k = 0; k < LN_NR; ++k) { const int mk = m0 + k * NGW; ok[k] = mk < T; m[k] = ok[k] ? mk : m0; }
        ln_rows<LN_NR>(c, a, m, ok, R, xin, xb, g, be, last, which == 0 && !dry);
    }
}
DI void ph_ln_handoff(const Ctx& c, CArgs a, int layer, unsigned* ho) {
    static_assert(T == 34816 && DM == 1024, "HandoffOrder and the task table assume 136 x 4 units");
    const bf16* R = (const bf16*)(a->ws + WS_MIX); bf16* xb = (bf16*)(a->ws + WS_XB);
    const float* g = a->in[23] + ((size_t)layer * 2) * DM; const float* be = a->in[24] + ((size_t)layer * 2) * DM;
    volatile LAS unsigned* tkw = (volatile LAS unsigned*)(c.lds + MISC_OFF) + 17;
    for (;;) {
        __syncthreads();
        if (c.tid == 0) {
            const unsigned tk = __hip_atomic_fetch_add(ho, 1u, __ATOMIC_RELAXED, __HIP_MEMORY_SCOPE_AGENT);
            if (tk < 320u) {
                const unsigned rt = tk < 256u ? (tk >> 1) : 128u + ((tk - 256u) >> 3); unsigned sp = 0u;
                while (__hip_atomic_load(ho + HO_ROWT + rt, __ATOMIC_RELAXED, __HIP_MEMORY_SCOPE_AGENT) < 4u) { __builtin_amdgcn_s_sleep(1); if (++sp > (1u << 24)) break; }
                __builtin_amdgcn_fence(__ATOMIC_ACQUIRE, "agent");
                asm volatile("s_waitcnt vmcnt(0)" ::: "memory");
            }
            *tkw = tk;
        }
        __syncthreads();
        const unsigned tk = *tkw;
        if (tk >= 320u) break;
        const int row0 = tk < 256u ? (int)tk * 128 : 32768 + (int)(tk - 256u) * 32, nr = tk < 256u ? 16 : 4;
        for (int i = 0; i < nr; i += 4) { int m[4]; bool ok[4];
#pragma unroll
            for (int k = 0; k < 4; ++k) { m[k] = row0 + (i + k) * NWAVES + c.wave; ok[k] = true; }
            ln_rows<4>(c, a, m, ok, R, xb, xb, g, be, false, true); }
    }
}

DI unsigned f2key(float f) { const unsigned u = __float_as_uint(f); return (u & 0x80000000u) ? ~u : (u | 0x80000000u); }
DI float key2f(unsigned k) { return __uint_as_float((k & 0x80000000u) ? (k & 0x7fffffffu) : ~k); }
#define CE(x, y) do { const unsigned hi_ = (x) > (y) ? (x) : (y), lo_ = (x) > (y) ? (y) : (x); (x) = hi_; (y) = lo_; } while (0)
DI void sort16(unsigned (&v)[16]) { CE(v[0],v[1]); CE(v[2],v[3]); CE(v[0],v[2]); CE(v[1],v[3]); CE(v[1],v[2]); CE(v[4],v[5]); CE(v[6],v[7]); CE(v[4],v[6]); CE(v[5],v[7]); CE(v[5],v[6]); CE(v[0],v[4]); CE(v[2],v[6]); CE(v[2],v[4]); CE(v[1],v[5]); CE(v[3],v[7]); CE(v[3],v[5]); CE(v[1],v[2]); CE(v[3],v[4]); CE(v[5],v[6]); CE(v[8],v[9]); CE(v[10],v[11]); CE(v[8],v[10]); CE(v[9],v[11]); CE(v[9],v[10]); CE(v[12],v[13]); CE(v[14],v[15]); CE(v[12],v[14]); CE(v[13],v[15]); CE(v[13],v[14]); CE(v[8],v[12]); CE(v[10],v[14]); CE(v[10],v[12]); CE(v[9],v[13]); CE(v[11],v[15]); CE(v[11],v[13]); CE(v[9],v[10]); CE(v[11],v[12]); CE(v[13],v[14]); CE(v[0],v[8]); CE(v[4],v[12]); CE(v[4],v[8]); CE(v[2],v[10]); CE(v[6],v[14]); CE(v[6],v[10]); CE(v[2],v[4]); CE(v[6],v[8]); CE(v[10],v[12]); CE(v[1],v[9]); CE(v[5],v[13]); CE(v[5],v[9]); CE(v[3],v[11]); CE(v[7],v[15]); CE(v[7],v[11]); CE(v[3],v[5]); CE(v[7],v[9]); CE(v[11],v[13]); CE(v[1],v[2]); CE(v[3],v[4]); CE(v[5],v[6]); CE(v[7],v[8]); CE(v[9],v[10]); CE(v[11],v[12]); CE(v[13],v[14]); }
DI void merge16(unsigned (&A)[16], const unsigned (&B)[16]) {
#pragma unroll
    for (int i = 0; i < 16; ++i) A[i] = A[i] > B[15 - i] ? A[i] : B[15 - i];
#pragma unroll
    for (int s = 8; s >= 1; s >>= 1)
#pragma unroll
        for (int i = 0; i < 16; ++i) if ((i & s) == 0) CE(A[i], A[i + s]);
}
DI unsigned byte_of(const unsigned (&W)[4], int i) { const int q = i >> 2; const unsigned w = q == 0 ? W[0] : q == 1 ? W[1] : q == 2 ? W[2] : W[3]; return (w >> ((i & 3) * 8)) & 0x7fu; }
DI void ph_topk(const Ctx& c, CArgs a, int layer) {
    const bf16* PQ = (const bf16*)(a->ws + WS_PQ); unsigned short* EIDX = (unsigned short*)(a->ws + WS_EIDX); float* GATE = (float*)(a->ws + WS_GATE);
    LAS v4u* ska = (LAS v4u*)(c.lds + RING_OFF);
    { const v4u* src = (const v4u*)(a->ws + WS_SKT) + (size_t)layer * 4096; for (int i = c.tid; i < 4096; i += NWAVES * 64) ska[i] = src[i]; }
    __syncthreads();
    const int gw = c.vcu * NWAVES + c.wave, NGW = c.G * NWAVES, lane = c.lane, r32 = lane & 31, hi = lane >> 5;
    typedef float f32x16 __attribute__((ext_vector_type(16)));
    bf16x8 qn0[8], qn1[8];
#define LDQ(tile_) do { const bf16* qp_ = PQ + (size_t)((tile_) * 32 + r32) * 256 + 8 * hi; _Pragma("unroll") for (int ks = 0; ks < 8; ++ks) { qn0[ks] = *(const bf16x8*)(qp_ + 16 * ks); qn1[ks] = *(const bf16x8*)(qp_ + 128 + 16 * ks); } } while (0)
    if (gw < T * 8 / 32) LDQ(gw);
    for (int tile = gw; tile < T * 8 / 32; tile += NGW) {
        const int prob = tile * 32 + r32;
        unsigned top0[16], top1[16];
        bf16x8 qc0[8], qc1[8];
#pragma unroll
        for (int ks = 0; ks < 8; ++ks) { qc0[ks] = qn0[ks]; qc1[ks] = qn1[ks]; }
#define TOPK_HALF(k, TOP, qf) do { \
            f32x16 acc[4]; \
            _Pragma("unroll") for (int j = 0; j < 4; ++j) { acc[j] = f32x16{}; \
                _Pragma("unroll") for (int ks = 0; ks < 8; ++ks) acc[j] = __builtin_amdgcn_mfma_f32_32x32x16_bf16(__builtin_bit_cast(bf16x8, ska[(((k) * 4 + j) * 8 + ks) * 64 + lane]), qf[ks], acc[j], 0, 0, 0); } \
            __builtin_amdgcn_sched_barrier(0); unsigned v0[16], v1[16], v2[16], v3[16]; \
            _Pragma("unroll") for (int r = 0; r < 16; ++r) { const unsigned kn = (unsigned)((r & 3) + 8 * (r >> 2) + 4 * hi); \
                v0[r] = (f2key(acc[0][r]) & ~0x7fu) | kn; v1[r] = (f2key(acc[1][r]) & ~0x7fu) | (32u + kn); v2[r] = (f2key(acc[2][r]) & ~0x7fu) | (64u + kn); v3[r] = (f2key(acc[3][r]) & ~0x7fu) | (96u + kn); } \
            __builtin_amdgcn_sched_barrier(0); sort16(v0); sort16(v1); __builtin_amdgcn_sched_barrier(0); merge16(v0, v1); __builtin_amdgcn_sched_barrier(0); sort16(v2); sort16(v3); __builtin_amdgcn_sched_barrier(0); merge16(v2, v3); __builtin_amdgcn_sched_barrier(0); merge16(v0, v2); __builtin_amdgcn_sched_barrier(0); \
            _Pragma("unroll") for (int i = 0; i < 16; ++i) v1[i] = (unsigned)__shfl_xor((int)v0[i], 32); \
            merge16(v0, v1); \
            _Pragma("unroll") for (int i = 0; i < 16; ++i) TOP[i] = v0[i]; } while (0)
        TOPK_HALF(0, top0, qc0); asm volatile("" ::: "memory"); __builtin_amdgcn_sched_barrier(0); TOPK_HALF(1, top1, qc1); asm volatile("" ::: "memory"); __builtin_amdgcn_sched_barrier(0);
        if (tile + NGW < T * 8 / 32) LDQ(tile + NGW);
#undef TOPK_HALF
        float f0[16], f1[16]; unsigned W0[4] = {0u, 0u, 0u, 0u}, W1[4] = {0u, 0u, 0u, 0u};
#pragma unroll
        for (int i = 0; i < 16; ++i) { f0[i] = key2f(top0[i] & ~0x7fu); f1[i] = key2f(top1[i] & ~0x7fu); W0[i >> 2] |= (top0[i] & 0x7fu) << ((i & 3) * 8); W1[i >> 2] |= (top1[i] & 0x7fu) << ((i & 3) * 8); }
#define CKEY(i, j) ((f2key(f0[i] + f1[j]) & ~0xffu) | (unsigned)(((i) << 4) | (j)))
        unsigned G0[16], G1[16], G2[16], G3[16];
#pragma unroll
        for (int j = 0; j < 16; ++j) { G0[j] = CKEY(0, j); G1[j] = j < 8 ? CKEY(1, j) : 0u; }
        G2[0] = CKEY(2, 0); G2[1] = CKEY(2, 1); G2[2] = CKEY(2, 2); G2[3] = CKEY(2, 3); G2[4] = CKEY(2, 4); G2[5] = CKEY(3, 0); G2[6] = CKEY(3, 1); G2[7] = CKEY(3, 2); G2[8] = CKEY(3, 3);
        G2[9] = CKEY(4, 0); G2[10] = CKEY(4, 1); G2[11] = CKEY(4, 2); G2[12] = CKEY(5, 0); G2[13] = CKEY(5, 1); G2[14] = CKEY(6, 0); G2[15] = CKEY(6, 1);
        G3[0] = CKEY(7, 0); G3[1] = CKEY(7, 1); G3[2] = CKEY(8, 0); G3[3] = CKEY(9, 0); G3[4] = CKEY(10, 0); G3[5] = CKEY(11, 0); G3[6] = CKEY(12, 0); G3[7] = CKEY(13, 0); G3[8] = CKEY(14, 0); G3[9] = CKEY(15, 0);
#pragma unroll
        for (int i = 10; i < 16; ++i) G3[i] = 0u;
#undef CKEY
        __builtin_amdgcn_sched_barrier(0); merge16(G0, G1); __builtin_amdgcn_sched_barrier(0); sort16(G2); sort16(G3); __builtin_amdgcn_sched_barrier(0); merge16(G2, G3); __builtin_amdgcn_sched_barrier(0); merge16(G0, G2); __builtin_amdgcn_sched_barrier(0);
        float ex[16]; int eo[16]; const float mx = key2f(G0[0] & ~0xffu); float sm = 0.f;
#pragma unroll
        for (int r = 0; r < 16; ++r) { const unsigned code = G0[r] & 0xffu; ex[r] = __expf(key2f(G0[r] & ~0xffu) - mx); sm += ex[r];
            eo[r] = (int)(byte_of(W0, (int)(code >> 4)) * 128u + byte_of(W1, (int)(code & 15u))); }
        const float inv = 1.f / sm;
        if (hi == 0) { unsigned short* ep = EIDX + (size_t)prob * 16;
#pragma unroll
            for (int q = 0; q < 2; ++q) *(v4u*)(ep + 8 * q) = (v4u){(unsigned)eo[8 * q] | ((unsigned)eo[8 * q + 1] << 16), (unsigned)eo[8 * q + 2] | ((unsigned)eo[8 * q + 3] << 16), (unsigned)eo[8 * q + 4] | ((unsigned)eo[8 * q + 5] << 16), (unsigned)eo[8 * q + 6] | ((unsigned)eo[8 * q + 7] << 16)}; }
        else { float* gp = GATE + (size_t)prob * 16;
#pragma unroll
            for (int q = 0; q < 4; ++q) *(f32x4*)(gp + 4 * q) = (f32x4){ex[4 * q] * inv, ex[4 * q + 1] * inv, ex[4 * q + 2] * inv, ex[4 * q + 3] * inv}; }
    }
    __syncthreads();
}
#undef CE

typedef float f32x2v __attribute__((ext_vector_type(2)));
DI void ph_tblcvt(const Ctx& c, CArgs a, int layer, int gw, int NGW, int row_lo, int row_hi) {
    const float* U = a->in[21] + (size_t)layer * NEXP * DM; const float* V = a->in[22] + (size_t)layer * NEXP * DM;
    unsigned char* T8 = a->ws + ((layer & 1) ? WS_T8B : WS_T8); float* SC = (float*)(a->ws + ((layer & 1) ? WS_TSCB : WS_TSC));
    const int lane = c.lane;
    for (int row = row_lo + gw; row < row_hi; row += NGW) {
        const float* src = (row < NEXP ? U + (size_t)row * DM : V + (size_t)(row - NEXP) * DM) + 16 * lane;
        f32x4 v[4]; float am = 0.f, ss = 0.f;
#pragma unroll
        for (int j = 0; j < 4; ++j) { v[j] = *(const f32x4*)(src + 4 * j); am = fmaxf(am, fmaxf(fmaxf(fabsf(v[j].x), fabsf(v[j].y)), fmaxf(fabsf(v[j].z), fabsf(v[j].w)))); ss += (v[j].x * v[j].x + v[j].y * v[j].y) + (v[j].z * v[j].z + v[j].w * v[j].w); }
        am = wave_max(am);
        const bool keyrow = row < NEXP; float inv; unsigned w2[2] = {0u, 0u};
        if (keyrow) {
            ss = wave_sum(ss); const float step = fmaxf(0.335f * sqrtf(ss * (1.f / DM)), 1e-30f), rs = 1.f / step; inv = step * (1.f / 16.f);
#pragma unroll
            for (int j = 0; j < 4; ++j) { const float x4[4] = {v[j].x, v[j].y, v[j].z, v[j].w};
#pragma unroll
                for (int i = 0; i < 4; ++i) { const int q = max(-8, min(7, __float2int_rn(x4[i] * rs))); const int el = 4 * j + i, c8 = el & 7, nib = (c8 < 4) ? 2 * c8 : 2 * (c8 - 4) + 1;
                    w2[el >> 3] |= ((unsigned)q & 0xfu) << (4 * nib); } }
        } else {
            const float sc = am > 0.f ? 6.f / am : 1.f; inv = am > 0.f ? am * (1.f / 6.f) : 1.f;
#pragma unroll
            for (int j = 0; j < 4; ++j) { const float x4[4] = {v[j].x * sc, v[j].y * sc, v[j].z * sc, v[j].w * sc};
#pragma unroll
                for (int i = 0; i < 4; ++i) { const float av = fabsf(x4[i]);
                    const unsigned mag = (unsigned)(av >= 0.25f) + (unsigned)(av >= 0.75f) + (unsigned)(av >= 1.25f) + (unsigned)(av >= 1.75f) + (unsigned)(av >= 2.5f) + (unsigned)(av >= 3.5f) + (unsigned)(av >= 5.f);
                    const unsigned code = mag | (x4[i] < 0.f ? 8u : 0u); const int el = 4 * j + i;
                    w2[el >> 3] |= code << (4 * (el & 7)); } }
        }
        { typedef unsigned u32x2t __attribute__((ext_vector_type(2)));
          *(u32x2t*)(T8 + (size_t)(row >> 14) * NEXP * DM + (size_t)(lane >> 4) * NEXP * 128 + (size_t)(row & (NEXP - 1)) * 128 + 8 * (lane & 15)) = (u32x2t){w2[0], w2[1]}; }
        if (lane == 0) SC[2 * (row & (NEXP - 1)) + (row >> 14)] = inv;
    }
}
DI void dec16(const v4u& r, float (&f)[16]) {
    const unsigned w[4] = {r.x, r.y, r.z, r.w};
#pragma unroll
    for (int j = 0; j < 4; ++j) { const f32x2v lo = __builtin_amdgcn_cvt_pk_f32_fp8((int)w[j], false), hi = __builtin_amdgcn_cvt_pk_f32_fp8((int)w[j], true);
        f[4 * j] = lo.x; f[4 * j + 1] = lo.y; f[4 * j + 2] = hi.x; f[4 * j + 3] = hi.y; }
}
DI void dec16p(const v4u& r, f32x2v (&f)[8]) {
    const unsigned w[4] = {r.x, r.y, r.z, r.w};
#pragma unroll
    for (int j = 0; j < 4; ++j) { f[2 * j] = __builtin_amdgcn_cvt_pk_f32_fp8((int)w[j], false); f[2 * j + 1] = __builtin_amdgcn_cvt_pk_f32_fp8((int)w[j], true); }
}
DI void gather_e16(const unsigned short* ep, int (&e)[16]) {
#pragma unroll
    for (int q = 0; q < 2; ++q) { const v4u v = *(const v4u*)(ep + 8 * q); const unsigned w[4] = {v.x, v.y, v.z, v.w};
#pragma unroll
        for (int i = 0; i < 4; ++i) { e[8 * q + 2 * i] = (int)(w[i] & (NEXP - 1)); e[8 * q + 2 * i + 1] = (int)((w[i] >> 16) & (NEXP - 1)); } }
}
DI void gather_rows(const unsigned char* base, const int (&e)[16], v4u (&r)[16]) {
#pragma unroll
    for (int i = 0; i < 16; ++i) r[i] = *(const v4u*)(base + (size_t)e[i] * 128);
}
DI void dec32p(const v4u& r, f32x2v (&f)[16]) {
    const unsigned w[4] = {r.x, r.y, r.z, r.w};
#pragma unroll
    for (int j = 0; j < 4; ++j) { f[4 * j] = __builtin_amdgcn_cvt_scalef32_pk_f32_fp4(w[j], 1.0f, 0); f[4 * j + 1] = __builtin_amdgcn_cvt_scalef32_pk_f32_fp4(w[j], 1.0f, 1);
        f[4 * j + 2] = __builtin_amdgcn_cvt_scalef32_pk_f32_fp4(w[j], 1.0f, 2); f[4 * j + 3] = __builtin_amdgcn_cvt_scalef32_pk_f32_fp4(w[j], 1.0f, 3); }
}
DI void ph_gather_u(const Ctx& c, CArgs a, int layer) {
    const unsigned short* EIDX = (const unsigned short*)(a->ws + WS_EIDX); bf16* PART = (bf16*)(a->ws + WS_PART); const unsigned char* U4 = a->ws + ((layer & 1) ? WS_T8B : WS_T8);
    const int lane = c.lane, j = lane >> 3, seg = lane & 7, c0 = lane & 1, c1 = (lane >> 1) & 1, c2 = (lane >> 2) & 1;
    const bool sl8 = (c.G & 7) == 0; const int nsl = sl8 ? 1 : 4, nloc = sl8 ? (c.G >> 3) : c.G, rank = sl8 ? (c.bx >> 3) : c.bx;
    const int hf = sl8 ? ((c.bx & 7) >> 2) : 0, nh = sl8 ? 2 : 1, Tn = (T - hf + nh - 1) / nh;
    const int tb = rank * NWAVES + c.wave, ts = nloc * NWAVES, nt = tb < Tn ? (Tn - tb + ts - 1) / ts : 0;
#define TOK(k) (hf + nh * (tb + ((k) < nt ? (k) : nt - 1) * ts))
    for (int si = 0; si < nsl; ++si) {
        const int slice = sl8 ? (c.bx & 3) : si;
        const unsigned char* ub = U4 + (size_t)slice * NEXP * 128 + 16 * seg; const unsigned char* xb = a->ws + WS_XQ + 256 * slice + 32 * seg;
#define LDX(X_, k) do { const v4u* xr_ = (const v4u*)(xb + (size_t)TOK(k) * DM); X_[0] = xr_[0]; X_[1] = xr_[1]; } while (0)
#define LDE(E_, k) do { const v4u* er_ = (const v4u*)(EIDX + (size_t)TOK(k) * 128 + 16 * j); E_[0] = er_[0]; E_[1] = er_[1]; } while (0)
#define ROWS(R_, E_) do { _Pragma("unroll") for (int i = 0; i < 16; ++i) { const unsigned ew_ = E_[i >> 3][(i >> 1) & 3]; const unsigned ei_ = ((i & 1) ? (ew_ >> 16) : ew_) & (NEXP - 1); R_[i] = *(const v4u*)(ub + (size_t)ei_ * 128); } } while (0)
#define COMPUTE_U(R_, X_, k) do { float d[16]; \
            _Pragma("unroll") for (int i = 0; i < 16; ++i) { const unsigned rw_[4] = {R_[i].x, R_[i].y, R_[i].z, R_[i].w}; int s_ = 0; \
                _Pragma("unroll") for (int q = 0; q < 4; ++q) { s_ = __builtin_amdgcn_sdot4((int)((rw_[q] << 4) & 0xF0F0F0F0u), (int)X_[q >> 1][2 * (q & 1)], s_, false); \
                    s_ = __builtin_amdgcn_sdot4((int)(rw_[q] & 0xF0F0F0F0u), (int)X_[q >> 1][2 * (q & 1) + 1], s_, false); } \
                d[i] = (float)s_; } \
            float n8[8], n4[4], n2[2];     \
            _Pragma("unroll") for (int q = 0; q < 8; ++q) { const float send = c0 ? d[q] : d[q + 8], keep = c0 ? d[q + 8] : d[q]; n8[q] = keep + dpp_xor1(send); } \
            _Pragma("unroll") for (int q = 0; q < 4; ++q) { const float send = c1 ? n8[q] : n8[q + 4], keep = c1 ? n8[q + 4] : n8[q]; n4[q] = keep + dpp_xor2(send); } \
            _Pragma("unroll") for (int q = 0; q < 2; ++q) { const float send = c2 ? n4[q] : n4[q + 2], keep = c2 ? n4[q + 2] : n4[q]; n2[q] = keep + swz_xor4(send); } \
            if ((k) < nt) *(unsigned*)(PART + ((size_t)slice * T + TOK(k)) * 128 + 16 * j + 8 * c0 + 4 * c1 + 2 * c2) = pk2(n2[0], n2[1]); } while (0)
        if (nt > 0) {
            v4u e[2], ra[16], rb[16], xa[2], xc[2];
            LDE(e, 0); LDX(xa, 0); ROWS(ra, e);
            LDE(e, 1); LDX(xc, 1);
            for (int k = 0; k < nt; k += 2) {
                __builtin_amdgcn_sched_barrier(0);
                ROWS(rb, e);
                LDE(e, k + 2);
                __builtin_amdgcn_sched_barrier(0);
                COMPUTE_U(ra, xa, k);
                LDX(xa, k + 2);
                __builtin_amdgcn_sched_barrier(0);
                ROWS(ra, e);
                LDE(e, k + 3);
                __builtin_amdgcn_sched_barrier(0);
                COMPUTE_U(rb, xc, k + 1);
                LDX(xc, k + 3);
            }
        }
#undef COMPUTE_U
#undef LDX
#undef LDE
#undef ROWS
    }
#undef TOK
}
DI void ph_gather_c(const Ctx& c, CArgs a, int layer) {
    const unsigned short* EIDX = (const unsigned short*)(a->ws + WS_EIDX); const float* GATE = (const float*)(a->ws + WS_GATE); const bf16* PART = (const bf16*)(a->ws + WS_PART); bf16* HH = (bf16*)(a->ws + WS_HH);
    typedef float f32x2s __attribute__((ext_vector_type(2))); const f32x2s* SC2 = (const f32x2s*)(a->ws + ((layer & 1) ? WS_TSCB : WS_TSC)); const float* SX = (const float*)(a->ws + WS_SX);
    const int gt = (c.vcu * NWAVES + c.wave) * 64 + c.lane, NT = c.G * NWAVES * 64;
    for (int it = gt; it < T * 16; it += NT) {
        const size_t base = (size_t)it * 8;
        const v4u p0 = *(const v4u*)(PART + base), p1 = *(const v4u*)(PART + (size_t)T * 128 + base), p2 = *(const v4u*)(PART + (size_t)2 * T * 128 + base), p3 = *(const v4u*)(PART + (size_t)3 * T * 128 + base);
        const v4u ev = *(const v4u*)(EIDX + base); const f32x4 g0 = *(const f32x4*)(GATE + base), g1 = *(const f32x4*)(GATE + base + 4);
        const float sx = SX[it >> 4];
        const unsigned ew[4] = {ev.x, ev.y, ev.z, ev.w}, w0[4] = {p0.x, p0.y, p0.z, p0.w}, w1[4] = {p1.x, p1.y, p1.z, p1.w}, w2[4] = {p2.x, p2.y, p2.z, p2.w}, w3[4] = {p3.x, p3.y, p3.z, p3.w};
        const float gt8[8] = {g0.x, g0.y, g0.z, g0.w, g1.x, g1.y, g1.z, g1.w};
        float su[8], sv[8];
#pragma unroll
        for (int q = 0; q < 8; ++q) { const int e = (int)((ew[q >> 1] >> (16 * (q & 1))) & (NEXP - 1)); const f32x2s sc = SC2[e]; su[q] = sc.x; sv[q] = sc.y; }
        float h[8];
#pragma unroll
        for (int q = 0; q < 8; ++q) { const int j = q >> 1;
            const float d = (q & 1) ? ((bfhi(w0[j]) + bfhi(w1[j])) + (bfhi(w2[j]) + bfhi(w3[j]))) : ((bflo(w0[j]) + bflo(w1[j])) + (bflo(w2[j]) + bflo(w3[j])));
            h[q] = gelu_erf(d * su[q] * sx) * gt8[q] * sv[q]; }
        *(v4u*)(HH + base) = (v4u){pk2(h[0], h[1]), pk2(h[2], h[3]), pk2(h[4], h[5]), pk2(h[6], h[7])};
    }
}
DI void ph_gather_v(const Ctx& c, CArgs a, int layer) {
    const unsigned short* EIDX = (const unsigned short*)(a->ws + WS_EIDX); const bf16* HH = (const bf16*)(a->ws + WS_HH); bf16* PE = (bf16*)(a->ws + WS_MIX); const unsigned char* V4 = a->ws + ((layer & 1) ? WS_T8B : WS_T8) + (size_t)NEXP * DM;
    const int lane = c.lane, j = lane >> 3, seg = lane & 7, b3 = (lane >> 3) & 1, b4 = (lane >> 4) & 1, b5 = (lane >> 5) & 1;
    const bool sl8 = (c.G & 7) == 0; const int nsl = sl8 ? 1 : 4, nloc = sl8 ? (c.G >> 3) : c.G, rank = sl8 ? (c.bx >> 3) : c.bx;
    const int hf = sl8 ? ((c.bx & 7) >> 2) : 0, nh = sl8 ? 2 : 1, Tn = (T - hf + nh - 1) / nh;
    const int tb = rank * NWAVES + c.wave, ts = nloc * NWAVES, nt = tb < Tn ? (Tn - tb + ts - 1) / ts : 0;
#define TOK(k) (hf + nh * (tb + ((k) < nt ? (k) : nt - 1) * ts))
    for (int si = 0; si < nsl; ++si) {
        const int slice = sl8 ? (c.bx & 3) : si;
        const unsigned char* vb = V4 + (size_t)slice * NEXP * 128 + 16 * seg;
#define LDH(H_, k) do { const v4u* hr_ = (const v4u*)(HH + (size_t)TOK(k) * 128 + 16 * j); H_[0] = hr_[0]; H_[1] = hr_[1]; } while (0)
#define LDE(E_, k) do { const v4u* er_ = (const v4u*)(EIDX + (size_t)TOK(k) * 128 + 16 * j); E_[0] = er_[0]; E_[1] = er_[1]; } while (0)
#define ROWS(R_, E_) do { _Pragma("unroll") for (int i = 0; i < 16; ++i) { const unsigned ew_ = E_[i >> 3][(i >> 1) & 3]; const unsigned ei_ = ((i & 1) ? (ew_ >> 16) : ew_) & (NEXP - 1); R_[i] = *(const v4u*)(vb + (size_t)ei_ * 128); } } while (0)
#define COMPUTE_V(R_, H_, k) do { f32x2v ac2[16]; \
            _Pragma("unroll") for (int q = 0; q < 16; ++q) ac2[q] = (f32x2v){0.f, 0.f}; \
            _Pragma("unroll") for (int i = 0; i < 16; ++i) { f32x2v f[16]; dec32p(R_[i], f); const unsigned hw_ = H_[i >> 3][(i >> 1) & 3]; const float hs = (i & 1) ? bfhi(hw_) : bflo(hw_); const f32x2v hh = (f32x2v){hs, hs}; \
                _Pragma("unroll") for (int q = 0; q < 16; ++q) ac2[q] = __builtin_elementwise_fma(f[q], hh, ac2[q]); } \
            float acc[32], n16[16], n8[8], n4[4]; \
            _Pragma("unroll") for (int q = 0; q < 16; ++q) { acc[2 * q] = ac2[q].x; acc[2 * q + 1] = ac2[q].y; } \
            _Pragma("unroll") for (int q = 0; q < 16; ++q) { const float send = b3 ? acc[q] : acc[q + 16], keep = b3 ? acc[q + 16] : acc[q]; n16[q] = keep + dpp_xor8(send); } \
            _Pragma("unroll") for (int q = 0; q < 8; ++q) { const float send = b4 ? n16[q] : n16[q + 8], keep = b4 ? n16[q + 8] : n16[q]; n8[q] = keep + swz_xor16(send); } \
            _Pragma("unroll") for (int q = 0; q < 4; ++q) { const float send = b5 ? n8[q] : n8[q + 4], keep = b5 ? n8[q + 4] : n8[q]; n4[q] = keep + xor32(send); } \
            if ((k) < nt) { typedef unsigned u32x2t __attribute__((ext_vector_type(2))); \
                *(u32x2t*)(PE + (size_t)TOK(k) * DM + 256 * slice + 32 * seg + 16 * b3 + 8 * b4 + 4 * b5) = (u32x2t){pk2(n4[0], n4[1]), pk2(n4[2], n4[3])}; } } while (0)
        if (nt > 0) {
            v4u e[2], ra[16], rb[16], ha[2], hc[2];
            LDE(e, 0); LDH(ha, 0); ROWS(ra, e);
            LDE(e, 1); LDH(hc, 1);
            for (int k = 0; k < nt; k += 2) {
                __builtin_amdgcn_sched_barrier(0);
                ROWS(rb, e);
                LDE(e, k + 2);
                __builtin_amdgcn_sched_barrier(0);
                COMPUTE_V(ra, ha, k);
                LDH(ha, k + 2);
                __builtin_amdgcn_sched_barrier(0);
                ROWS(ra, e);
                LDE(e, k + 3);
                __builtin_amdgcn_sched_barrier(0);
                COMPUTE_V(rb, hc, k + 1);
                LDH(hc, k + 3);
            }
        }
#undef COMPUTE_V
#undef LDH
#undef LDE
#undef ROWS
    }
#undef TOK
}

DI void ph_kvpost(const Ctx& c, CArgs a) {
    const float* LOGF = (const float*)(a->ws + WS_LOGF); float* BP = (float*)(a->ws + WS_BIASP); float* BS = (float*)(a->ws + WS_BIASS);
    const int gw = c.vcu * NWAVES + c.wave, NGW = c.G * NWAVES, lane = c.lane;
    constexpr float L2E = 1.4426950408889634f;
    for (int task = gw; task < PB * AH + SBT * AH; task += NGW) {
        if (task < PB * AH) {
            const int b = task >> 4, h = task & 15; const float bias = a->in[16][h]; float s = 0.f;
            for (int i = 0; i < 32; ++i) { const size_t r = (size_t)b * PL + lane * 32 + i; const float lf = logsigmoid_f(LOGF[r * 16 + h] + bias); a->out[O_PLOGF + r * 16 + h] = lf; s += lf; }
            float inc = s;
#pragma unroll
            for (int o = 1; o < 64; o <<= 1) { const float v = __shfl_up(inc, o); if (lane >= o) inc += v; }
            float run = inc - s;
            for (int i = 0; i < 32; ++i) { const size_t r = (size_t)b * PL + lane * 32 + i; run += a->out[O_PLOGF + r * 16 + h]; BP[(size_t)task * PL + lane * 32 + i] = -run * L2E; }
        } else {
            const int ts = task - PB * AH, b = ts >> 4, h = ts & 15; const float bias = a->in[16][h]; float s = 0.f;
            for (int i = 0; i < 17; ++i) { const int pos = lane * 17 + i; float lf;
                if (pos < PAST) lf = a->in[6][((size_t)b * PAST + pos) * 16 + h];
                else { const size_t r = (size_t)b * SL + (pos - PAST); lf = logsigmoid_f(LOGF[((size_t)TP + r) * 16 + h] + bias); a->out[O_SLOGF + r * 16 + h] = lf; }
                s += lf; }
            float inc = s;
#pragma unroll
            for (int o = 1; o < 64; o <<= 1) { const float v = __shfl_up(inc, o); if (lane >= o) inc += v; }
            float run = inc - s;
            for (int i = 0; i < 17; ++i) { const int pos = lane * 17 + i; float lf;
                if (pos < PAST) lf = a->in[6][((size_t)b * PAST + pos) * 16 + h]; else lf = a->out[O_SLOGF + ((size_t)b * SL + (pos - PAST)) * 16 + h];
                run += lf; BS[(size_t)ts * SKVP + pos] = -run * L2E; }
            BS[(size_t)ts * SKVP + SKV + lane] = 0.f;
        }
    }
    { bf16* KS = (bf16*)(a->ws + WS_KS); bf16* VS = (bf16*)(a->ws + WS_VS);
      for (int r = gw; r < SBT * (PAST + 64); r += NGW) {
          const int b = r / (PAST + 64), p = r % (PAST + 64);
          if (p < PAST) {
              const float* ks = a->in[4] + ((size_t)b * PAST + p) * 1024 + 16 * lane; const float* vs = a->in[5] + ((size_t)b * PAST + p) * 1024 + 16 * lane;
              v4u ok[2], ov[2];
#pragma unroll
              for (int q = 0; q < 2; ++q) { const f32x4 k0 = *(const f32x4*)(ks + 8 * q), k1 = *(const f32x4*)(ks + 8 * q + 4), v0 = *(const f32x4*)(vs + 8 * q), v1 = *(const f32x4*)(vs + 8 * q + 4);
                  ok[q] = (v4u){pk2(k0.x, k0.y), pk2(k0.z, k0.w), pk2(k1.x, k1.y), pk2(k1.z, k1.w)}; ov[q] = (v4u){pk2(v0.x, v0.y), pk2(v0.z, v0.w), pk2(v1.x, v1.y), pk2(v1.z, v1.w)}; }
              v4u* kd = (v4u*)(KS + ((size_t)b * SKVP + p) * 1024 + 16 * lane); v4u* vd = (v4u*)(VS + ((size_t)b * SKVP + p) * 1024 + 16 * lane);
              kd[0] = ok[0]; kd[1] = ok[1]; vd[0] = ov[0]; vd[1] = ov[1];
          } else {
              const int pz = SKV + (p - PAST); const v4u z = (v4u){0u, 0u, 0u, 0u};
              v4u* kd = (v4u*)(KS + ((size_t)b * SKVP + pz) * 1024 + 16 * lane); v4u* vd = (v4u*)(VS + ((size_t)b * SKVP + pz) * 1024 + 16 * lane);
              kd[0] = z; kd[1] = z; vd[0] = z; vd[1] = z;
          }
      } }
}

DI void ph_attn(const Ctx& c, CArgs a) {
    typedef attn_body::bf16 abf;
    const abf* QB = (const abf*)(a->ws + WS_QB); const abf* GB = (const abf*)(a->ws + WS_GB); abf* OG = (abf*)(a->ws + WS_OG);
    const abf* KP = (const abf*)(a->ws + WS_KP); const abf* VP = (const abf*)(a->ws + WS_VP); const abf* KS = (const abf*)(a->ws + WS_KS); const abf* VS = (const abf*)(a->ws + WS_VS);
    const float* BP = (const float*)(a->ws + WS_BIASP); const float* BS = (const float*)(a->ws + WS_BIASS);
    char* shm = (char*)(c.lds + RING_OFF);
    const int wid = c.wave;
    for (int s = c.vcu; s < PB * AH + SBT * AH; s += c.G) {
        const bool prompt = s < PB * AH; const int ss = prompt ? s : s - PB * AH, b = ss >> 4, h = ss & 15, nq = prompt ? PL / 256 : 1;
        const abf* Kh = (prompt ? KP + (size_t)b * PL * DM : KS + (size_t)b * SKVP * DM) + h * 64; const abf* Vh = (prompt ? VP + (size_t)b * PL * DM : VS + (size_t)b * SKVP * DM) + h * 64;
        const float* bias = prompt ? BP + (size_t)ss * PL : BS + (size_t)ss * SKVP;
        for (int qi = nq - 1; qi >= 0; --qi) {
            const int q0 = prompt ? qi * 256 : SKVP - 256;
            const long row = (prompt ? (long)b * PL + q0 : (long)TP + b * SL - 128) + wid * 32;
            const bool st_ok = prompt || wid == 4 || wid == 5;
            attn_body::attn_unit<20>(q0, QB + row * DM + h * 64, Kh, Vh, GB + row * DM + h * 64, OG + row * DM + h * 64, bias, qi == nq - 1 ? q0 + 256 : 0, st_ok, shm);
        }
    }
}

#ifndef HANDOFF
#define HANDOFF 1
#endif
#ifndef HO_SC1
#define HO_SC1 true
#endif
constexpr int N_PHASES = HANDOFF ? 42 : 46;
__global__ void __launch_bounds__(NWAVES * 64, 2) mk_fwd(Args args_unused) {
    extern __shared__ __attribute__((aligned(16))) unsigned char lds[];
    { const int t0 = threadIdx.x; for (int u = t0; u < (LDS_BYTES - LDSCTL_OFF) / 4; u += NWAVES * 64) ((LAS unsigned*)((LAS unsigned char*)lds + LDSCTL_OFF))[u] = 0u; }
    __syncthreads();
    volatile LAS unsigned* MISC = (volatile LAS unsigned*)((LAS unsigned char*)lds + MISC_OFF);
    int lo, hi; XcdBarrier bar;
    { CArgs a = kargs(); lo = a->ph_lo; hi = a->ph_hi; bar = xcd_barrier_post((unsigned*)(a->ws + WS_CTL) + CW_BAR + (size_t)a->li * XCD_BAR_WORDS, MISC + 8); }
    int pc = 0;
#define PH_BEGIN if (lo <= pc && pc < hi) { CArgs a = kargs(); const Ctx c = mkctx((LAS unsigned char*)lds);
#define PH_END   if (pc + 1 < hi) { for (int rb_ = 0; rb_ < RP_BAR; ++rb_) xcd_barrier(bar); } } ++pc;
#define RING (c.lds + RING_OFF)
#define WSP(T_, off) ((T_*)(a->ws + (off)))

    PH_BEGIN for (int r_ = 0; r_ < RP_PRO; ++r_) ph_prologue(c, a); PH_END

#if HANDOFF
#define LN1_PHASE(layer)
#define HO_GEMM(layer, A_, W_, K_) { unsigned* ho_ = WSP(unsigned, WS_CTL) + CW_HO + HO_STRIDE * (layer); \
                       pg8::Gemm g{A_, W_, T, 1024, K_}; pg8::HandoffOrderT<HO_SC1> S; S.init(c.G, c.bx, ho_ + HO_ROWT, (LAS unsigned*)(c.lds + MISC_OFF) + 16); \
                       pg8::EpiBf16<0, HO_SC1> E{WSP(bf16, WS_MIX), 1024, nullptr, 0, 0, 1.f}; \
                       pg8::gemm_phase<pg8::EpiBf16<0, HO_SC1>, pg8::HandoffOrderT<HO_SC1>, true, true>(RING, g, S, E); \
                       for (int r_ = 1; r_ < RP_LN; ++r_) ph_ln(c, a, layer, 0, true); ph_ln_handoff(c, a, layer, ho_); }
#else
#define LN1_PHASE(layer) PH_BEGIN for (int r_ = 1; r_ < RP_LN; ++r_) ph_ln(c, a, layer, 0, true); ph_ln(c, a, layer, 0); PH_END
#define HO_GEMM(layer, A_, W_, K_) { pg8::Gemm g{A_, W_, T, 1024, K_}; pg8::StaticOrder S; S.init(T, 1024, c.G, c.bx); \
                       pg8::EpiBf16<0> E{WSP(bf16, WS_MIX), 1024, nullptr, 0, 0, 1.f}; \
                       for (int r_ = 0; r_ < RP_GEMM; ++r_) pg8::gemm_phase<pg8::EpiBf16<0>, pg8::StaticOrder, true, true>(RING, g, S, E); }
#endif
#define TAIL_TBLCVT(lo_, hi_) do { const int busy_ = (T / 256) * 8 - 4 * c.G; const bool all_ = busy_ <= 0 || busy_ >= c.G; \
        if (all_ || c.bx >= busy_) ph_tblcvt(c, a, 3, ((all_ ? c.bx : c.bx - busy_)) * NWAVES + c.wave, (all_ ? c.G : c.G - busy_) * NWAVES, lo_, hi_); } while (0)
#define PEER_PHASES(layer) \
        LN1_PHASE(layer) \
        PH_BEGIN { pg8::Gemm g{WSP(const bf16, WS_XB), WSP(const bf16, WS_WPQ) + (size_t)(layer) * 2048 * 1024, T, 2048, 1024}; pg8::StaticOrder S; S.init(T, 2048, c.G, c.bx); \
                   pg8::EpiBf16<0> E{WSP(bf16, WS_PQ), 2048, nullptr, 0, 0, 1.f}; \
                   for (int r_ = 0; r_ < RP_GEMM; ++r_) pg8::gemm_phase<pg8::EpiBf16<0>, pg8::StaticOrder, true, true>(RING, g, S, E); \
                   if ((layer) == 2) TAIL_TBLCVT(NEXP, 2 * NEXP); } PH_END \
        PH_BEGIN for (int r_ = 0; r_ < RP_TOPK; ++r_) ph_topk(c, a, layer); PH_END \
        PH_BEGIN for (int r_ = 0; r_ < RP_GATHER * RP_GU; ++r_) ph_gather_u(c, a, layer); PH_END \
        PH_BEGIN for (int r_ = 0; r_ < RP_GC; ++r_) ph_gather_c(c, a, layer); PH_END \
        PH_BEGIN for (int r_ = 0; r_ < RP_GATHER; ++r_) ph_gather_v(c, a, layer); PH_END \
        PH_BEGIN for (int r_ = 1; r_ < RP_LN; ++r_) ph_ln(c, a, layer, 1, true); ph_ln(c, a, layer, 1); PH_END
#define LAYER_A(layer) \
            PH_BEGIN { pg8::Gemm g{WSP(const bf16, WS_XB), WSP(const bf16, WS_WIN) + (size_t)(layer) * IN_PAD * 1024, T, IN_PAD, 1024}; pg8::StaticOrder S; S.init(T, IN_PAD, c.G, c.bx); \
                       pg8::EpiInproj E{WSP(bf16, WS_R1), WSP(float, WS_DT)}; \
                       for (int r_ = 0; r_ < RP_GEMM; ++r_) pg8::gemm_phase<pg8::EpiInproj, pg8::StaticOrder, true, true>(RING, g, S, E); } PH_END \
            PH_BEGIN for (int r_ = 0; r_ < RP_CONV; ++r_) ph_ssdprep(c, a, layer); PH_END \
            PH_BEGIN for (int r_ = 0; r_ < RP_SCAN; ++r_) ph_scan(c, a, layer); PH_END \
            PH_BEGIN ph_gnorm(c, a, layer); PH_END \
            PH_BEGIN HO_GEMM(layer, WSP(const bf16, WS_Y), WSP(const bf16, WS_WOUT) + (size_t)(layer) * 1024 * 2048, 2048) PH_END \
            PEER_PHASES(layer)
#define LAYER_B(layer) \
            PH_BEGIN if ((layer) == 2) { for (int r_ = 0; r_ < RP_KVP; ++r_) ph_kvpost(c, a); __syncthreads(); } \
                     { pg8::Gemm g{WSP(const bf16, WS_XB), WSP(const bf16, WS_WQG) + (size_t)((layer) - 2) * 2048 * 1024, T, 2048, 1024}; pg8::StaticOrder S; S.init(T, 2048, c.G, c.bx); \
                       pg8::EpiBf16<0> E{WSP(bf16, WS_QB), 1024, nullptr, 1024, (size_t)(WS_GB - WS_QB) / 2, attn_body::C2}; \
                       for (int r_ = 0; r_ < RP_GEMM; ++r_) pg8::gemm_phase<pg8::EpiBf16<0>, pg8::StaticOrder, true, true>(RING, g, S, E); \
                       if ((layer) == 2) TAIL_TBLCVT(0, NEXP); } PH_END \
            PH_BEGIN for (int r_ = 0; r_ < RP_ATTN; ++r_) ph_attn(c, a); PH_END \
            PH_BEGIN HO_GEMM(layer, WSP(const bf16, WS_OG), WSP(const bf16, WS_WO) + (size_t)((layer) - 2) * 1024 * 1024, 1024) PH_END \
            PEER_PHASES(layer)

    LAYER_A(0)
    LAYER_A(1)
    PH_BEGIN { pg8::Gemm g{WSP(const bf16, WS_XB), WSP(const bf16, WS_WKV), T, KVPAD, 1024}; pg8::StaticOrder S; S.init(T, KVPAD, c.G, c.bx);
               pg8::EpiKV E{WSP(bf16, WS_KP), WSP(bf16, WS_VP), WSP(bf16, WS_KS), WSP(bf16, WS_VS), WSP(float, WS_LOGF), a->out};
               for (int r_ = 0; r_ < RP_GEMM; ++r_) pg8::gemm_phase<pg8::EpiKV, pg8::StaticOrder, true, true>(RING, g, S, E); } PH_END
    LAYER_B(2)
    LAYER_B(3)
#undef PH_BEGIN
#undef PH_END
}

#ifndef MK_N_LAUNCHES
#define MK_N_LAUNCHES 1
#endif
extern "C" void kernel_launch(void* const* d_in, const int* in_sizes, int n_in, void* d_out, int out_size, void* d_ws, size_t ws_size, hipStream_t stream) {
    static int grid = 0;
    if (grid == 0) {
        if (n_in != 25 || out_size != (int)O_END || ws_size < WS_END) { fprintf(stderr, "kernel_launch: unexpected shapes: n_in %d out %d ws %zu\n", n_in, out_size, ws_size); grid = -1; return; }
        int dev = 0, cus = 0, per_cu = 0;
        if (hipGetDevice(&dev) != hipSuccess || hipDeviceGetAttribute(&cus, hipDeviceAttributeMultiprocessorCount, dev) != hipSuccess) { grid = -1; return; }
        if (hipFuncSetAttribute((const void*)mk_fwd, hipFuncAttributeMaxDynamicSharedMemorySize, LDS_BYTES) != hipSuccess) { fprintf(stderr, "kernel_launch: hipFuncSetAttribute failed\n"); grid = -1; return; }
        if (hipOccupancyMaxActiveBlocksPerMultiprocessor(&per_cu, (const void*)mk_fwd, NWAVES * 64, LDS_BYTES) != hipSuccess || per_cu < 1) { fprintf(stderr, "kernel_launch: occupancy query says %d\n", per_cu); }
        (void)hipGetLastError();
        grid = cus;
    }
    if (grid < 0) return;
    if (hipMemsetAsync((char*)d_ws + WS_CTL, 0, CTL_ZERO_BYTES, stream) != hipSuccess) return;
    Args a{};
    for (int i = 0; i < 25; ++i) a.in[i] = (const float*)d_in[i];
    a.out = (float*)d_out; a.ws = (unsigned char*)d_ws; a.pad = 0;
    constexpr int NL = MK_N_LAUNCHES;
    static_assert(NL >= 1 && NL <= MAX_BAR_REGIONS && NL <= N_PHASES, "launch count");
    for (int li = 0; li < NL; ++li) {
        a.ph_lo = (int)((long)li * N_PHASES / NL); a.ph_hi = (int)((long)(li + 1) * N_PHASES / NL); a.li = li;
        hipLaunchKernelGGL(mk_fwd, dim3(grid), dim3(NWAVES * 64), LDS_BYTES, stream, a);
        const hipError_t le = hipPeekAtLastError();
        if (le != hipSuccess) { fprintf(stderr, "kernel_launch: launch %d failed: %s\n", li, hipGetErrorName(le)); break; }
    }
}
```

```cpp
#include <hip/hip_runtime.h>
#include <cstdio>
#include <cstdint>
namespace pg8 {
#define PG8_LAS __attribute__((address_space(3)))
typedef unsigned short bf16_t;
typedef short bf16x8 __attribute__((ext_vector_type(8)));
typedef float f32x4 __attribute__((ext_vector_type(4)));
typedef unsigned u32x4 __attribute__((ext_vector_type(4)));
constexpr int BM = 256, BK = 64, HALF = 128, HTB = HALF * BK * 2  , STAGE_BYTES = 8 * HTB, NXCD = 8, WGM = 4;

__host__ __device__ __forceinline__ int lds_byte(int r, int c) { const int st = (r >> 4) * 2 + (c >> 5), rr = r & 15, cc = c & 31, ob = rr * 64 + cc * 2; return st * 1024 + (ob ^ (((ob >> 9) & 1) << 5)); }
__host__ __device__ __forceinline__ void stage_rc(int b, int& R, int& C) { const int st = b / 1024, sb = b % 1024, swz = sb ^ (((sb >> 9) & 1) << 5); R = (st >> 1) * 16 + swz / 64; C = (st & 1) * 32 + (swz % 64) / 2; }
__host__ __device__ __forceinline__ int perm32(int rho) { const int n = rho >> 4, i = rho & 15; return 8 * (i >> 2) + 4 * n + (i & 3); }

struct Unit { int pm, pn; };
struct Gemm { const bf16_t* A; const bf16_t* Bt; int M, N, K; };

struct StaticOrder {
    int nM, nN, nwg, G, c;
    __host__ __device__ void init(int M, int N, int G_, int c_) { nM = M / BM; nN = N / BM; nwg = nM * nN; G = G_; c = c_; }
    __host__ __device__ bool next(int i, Unit& u) const {
        const long L = (long)i * G + c; if (L >= nwg) return false;
        int wgid = (int)L; { const int q = nwg / NXCD, r = nwg % NXCD, xcd = wgid % NXCD, off = wgid / NXCD; wgid = (xcd < r ? xcd * (q + 1) : r * (q + 1) + (xcd - r) * q) + off; }
        const int nig = WGM * nN, gid = wgid / nig, fm = gid * WGM, gsz = (nM - fm) < WGM ? (nM - fm) : WGM;
        u.pm = fm + ((wgid % nig) % gsz); u.pn = (wgid % nig) / gsz; return true;
    }
    __device__ __forceinline__ void a_ready(const Unit&) const {}
    __device__ __forceinline__ void done(const Unit&) const {}
};

struct WindowOrder {
    StaticOrder base; int first_i, n_i;
    __device__ __forceinline__ bool next(int j, Unit& u) const { return j < n_i && base.next(first_i + j, u); }
    __device__ __forceinline__ void a_ready(const Unit&) const {}
    __device__ __forceinline__ void done(const Unit&) const {}
};

template <bool SC1> struct HandoffOrderT {
    int G, c; unsigned* cnt; PG8_LAS unsigned* lcnt;
    __device__ void init(int G_, int c_, unsigned* cnt_, PG8_LAS unsigned* lcnt_) { G = G_; c = c_; cnt = cnt_; lcnt = lcnt_; }
    __device__ __forceinline__ bool next(int i, Unit& u) const {
        const long L = (long)i * G + c; if (L >= 544) return false;
        const int l = (int)L;
        if (l < 512) { const int xcd = l & 7, off = l >> 3, idx = off & 15; u.pm = 16 * xcd + 4 * (off >> 4) + (idx & 3); u.pn = idx >> 2; }
        else { const int k = l - 512; u.pm = 128 + (k & 7); u.pn = k >> 3; }
        return true;
    }
    __device__ __forceinline__ void a_ready(const Unit&) const {}
    __device__ __forceinline__ void done(const Unit& u) const {
        asm volatile("s_waitcnt vmcnt(0)" ::: "memory");
        unsigned prev = 0u;
        if ((threadIdx.x & 63) == 0) prev = __hip_atomic_fetch_add(lcnt, 1u, __ATOMIC_RELAXED, __HIP_MEMORY_SCOPE_WORKGROUP);
        prev = (unsigned)__builtin_amdgcn_readfirstlane((int)prev);
        if ((prev & 7u) == 7u && (threadIdx.x & 63) == 0) {
            if constexpr (!SC1) { __builtin_amdgcn_fence(__ATOMIC_RELEASE, "agent");
                asm volatile("s_waitcnt vmcnt(0)" ::: "memory"); }
            (void)__hip_atomic_fetch_add(cnt + u.pm, 1u, __ATOMIC_RELAXED, __HIP_MEMORY_SCOPE_AGENT);
        }
    }
};

__device__ __forceinline__ unsigned cvt_pk_bf16(float lo, float hi) { unsigned r; asm volatile("v_cvt_pk_bf16_f32 %0, %1, %2" : "=v"(r) : "v"(lo), "v"(hi)); return r; }
typedef float f32x2 __attribute__((ext_vector_type(2)));
__device__ __forceinline__ f32x2 gelu_pk(f32x2 v) {
    const f32x2 av = __builtin_elementwise_abs(v), d = av * 0.2316418882f + 1.0f;
    f32x2 t; t.x = __builtin_amdgcn_rcpf(d.x); t.y = __builtin_amdgcn_rcpf(d.y);
    f32x2 q = t * 0.5307027145f + (-0.7265760135f); q = q * t + 0.7107068705f; q = q * t + (-0.142248368f); q = q * t + 0.127414796f; q = q * t;
    const f32x2 s = (v * v) * (-0.72134752044f);
    f32x2 e; e.x = __builtin_amdgcn_exp2f(s.x); e.y = __builtin_amdgcn_exp2f(s.y);
    const f32x2 m = v * (q * e), r = v - m;
    f32x2 o; o.x = v.x < 0.f ? m.x : r.x; o.y = v.y < 0.f ? m.y : r.y; return o;
}

template <int ACT  , bool SC1 = false  > struct EpiBf16 {
    static constexpr bool PERM = true, AFTER_DRAIN = false; static_assert(ACT == 0 || ACT == 1, "EpiBf16: ACT is 0 (none) or 1 (gelu_pk)");
    bf16_t* O; int ldc; const float* bias; int split_cols; size_t split_stride; float scale0;
    __device__ __forceinline__ void operator()(const f32x4 (&acc)[2][2][4][2], const Unit& u, int wr, int wc, int fr, int fq) const {
        const int row0 = u.pm * BM + wr * 64 + fr; int colt = u.pn * BM; bf16_t* base = O;
        float sc = 1.f; if (split_cols) { const int t = colt / split_cols; base += (size_t)t * split_stride; colt -= t * split_cols; if (t == 0) sc = scale0; }
        const int col0 = colt + wc * 32 + 8 * fq, bcol0 = u.pn * BM + wc * 32 + 8 * fq;
        f32x4 bv[2][2];
#pragma unroll
        for (int bj = 0; bj < 2; ++bj)
#pragma unroll
            for (int n = 0; n < 2; ++n) bv[bj][n] = bias ? *(const f32x4*)(bias + bcol0 + bj * HALF + 4 * n) : (f32x4){0.f, 0.f, 0.f, 0.f};
#pragma unroll
        for (int ai = 0; ai < 2; ++ai)
#pragma unroll
            for (int m = 0; m < 4; ++m) { bf16_t* rowp = base + (size_t)(row0 + ai * HALF + m * 16) * ldc + col0;
#pragma unroll
                for (int bj = 0; bj < 2; ++bj) { f32x4 v0 = acc[ai][bj][m][0] + bv[bj][0], v1 = acc[ai][bj][m][1] + bv[bj][1];
                    if (ACT == 1) { f32x2 a = gelu_pk((f32x2){v0[0], v0[1]}), b = gelu_pk((f32x2){v0[2], v0[3]}), c = gelu_pk((f32x2){v1[0], v1[1]}), d = gelu_pk((f32x2){v1[2], v1[3]});
                        v0 = (f32x4){a.x, a.y, b.x, b.y}; v1 = (f32x4){c.x, c.y, d.x, d.y}; }
                    v0 = v0 * sc; v1 = v1 * sc; u32x4 w; w.x = cvt_pk_bf16(v0[0], v0[1]); w.y = cvt_pk_bf16(v0[2], v0[3]); w.z = cvt_pk_bf16(v1[0], v1[1]); w.w = cvt_pk_bf16(v1[2], v1[3]);
                    if constexpr (SC1) { asm volatile("global_store_dwordx4 %0, %1, off sc1\n\ts_nop 1" :: "v"(rowp + bj * HALF), "v"(w) : "memory"); }
                    else *(u32x4*)(rowp + bj * HALF) = w; } }
    }
};

struct EpiF32 {
    static constexpr bool PERM = false, AFTER_DRAIN = false;
    float* C; int ldc; const float* bias;
    __device__ __forceinline__ void operator()(const f32x4 (&acc)[2][2][4][2], const Unit& u, int wr, int wc, int fr, int fq) const {
        const int row0 = u.pm * BM + wr * 64 + fr, col0 = u.pn * BM + wc * 32 + 4 * fq;
        f32x4 bv[2][2];
#pragma unroll
        for (int bj = 0; bj < 2; ++bj)
#pragma unroll
            for (int n = 0; n < 2; ++n) bv[bj][n] = bias ? *(const f32x4*)(bias + col0 + bj * HALF + n * 16) : (f32x4){0.f, 0.f, 0.f, 0.f};
#pragma unroll
        for (int ai = 0; ai < 2; ++ai)
#pragma unroll
            for (int m = 0; m < 4; ++m) { float* rowp = C + (size_t)(row0 + ai * HALF + m * 16) * ldc + col0;
#pragma unroll
                for (int bj = 0; bj < 2; ++bj)
#pragma unroll
                    for (int n = 0; n < 2; ++n) *(f32x4*)(rowp + bj * HALF + n * 16) = acc[ai][bj][m][n] + bv[bj][n]; }
    }
};

template <class Epi, class Sched, bool ALIGN_EPI = false, bool SP2 = false>
__device__ __forceinline__ void gemm_phase(PG8_LAS unsigned char* lds, const Gemm g, const Sched& S, const Epi& E) {
    int tid_ = threadIdx.x; asm volatile("" : "+v"(tid_));
    const int tid = tid_, wid = __builtin_amdgcn_readfirstlane(tid >> 6), lane = tid & 63, wr = wid >> 2, wc = wid & 3, fr = lane & 15, fq = lane >> 4;
    const int K = g.K, nt = K / BK;
    unsigned voffA[2], voffB[2];
#pragma unroll
    for (int i = 0; i < 2; ++i) { int R, C; stage_rc(tid * 16 + i * 8192, R, C); const int Rb = Epi::PERM ? ((R & ~31) + perm32(R & 31)) : R;
        voffA[i] = (unsigned)(R * K + C) * 2u; voffB[i] = (unsigned)(Rb * K + C) * 2u; }
    const size_t kstep = (size_t)(BK * 2);
    const size_t hstep = (size_t)HALF * K * 2;
    const size_t tstep = 2 * hstep;
    const unsigned ldsw = (unsigned)wid * 1024u;
    const int aoff = lds_byte(wr * 64 + fr, fq * 8), boff = lds_byte(wc * 32 + fr, fq * 8);
#define PG8_SA(b, h) (((b) * 2 + (h)) * HTB)
#define PG8_SB(b, h) ((4 + (b) * 2 + (h)) * HTB)
#define PG8_STAGE(bufoff, gbase, voff) do { _Pragma("unroll") for (int _i = 0; _i < 2; ++_i) \
        __builtin_amdgcn_global_load_lds((const unsigned*)((const char*)(gbase) + (voff)[_i]), (PG8_LAS unsigned*)(lds + (bufoff) + ldsw + _i * 8192), 16, 0, 0); } while (0)
#define PG8_LDA(dst, b, h) do { _Pragma("unroll") for (int m = 0; m < 4; ++m) _Pragma("unroll") for (int k = 0; k < 2; ++k) dst[m][k] = *(const PG8_LAS bf16x8*)(lds + PG8_SA(b, h) + aoff + m * 2048 + k * 1024); } while (0)
#define PG8_LDB(dst, b, h) do { _Pragma("unroll") for (int n = 0; n < 2; ++n) _Pragma("unroll") for (int k = 0; k < 2; ++k) dst[n][k] = *(const PG8_LAS bf16x8*)(lds + PG8_SB(b, h) + boff + n * 2048 + k * 1024); } while (0)
#define PG8_MMA(ai, bj, At, Bt) do { __builtin_amdgcn_s_setprio(1); _Pragma("unroll") for (int m = 0; m < 4; ++m) _Pragma("unroll") for (int n = 0; n < 2; ++n) _Pragma("unroll") for (int k = 0; k < 2; ++k) \
        acc[ai][bj][m][n] = __builtin_amdgcn_mfma_f32_16x16x32_bf16(Bt[n][k], At[m][k], acc[ai][bj][m][n], 0, 0, 0); __builtin_amdgcn_s_setprio(0); } while (0)
#define PG8_WAIT_V(n) asm volatile("s_waitcnt vmcnt(" #n ")" ::: "memory")
#define PG8_WAIT_L(n) asm volatile("s_waitcnt lgkmcnt(" #n ")" ::: "memory")
#define PG8_BAR __builtin_amdgcn_s_barrier()
#define PG8_SCHED __builtin_amdgcn_sched_barrier(0)
    Unit cur, nxt; int ui = 0;
    if (!S.next(0, cur)) return;
    f32x4 acc[2][2][4][2];
#pragma unroll
    for (int a = 0; a < 2; ++a)
#pragma unroll
        for (int b = 0; b < 2; ++b)
#pragma unroll
            for (int m = 0; m < 4; ++m)
#pragma unroll
                for (int n = 0; n < 2; ++n) acc[a][b][m][n] = (f32x4){0.f, 0.f, 0.f, 0.f};
    bf16x8 At[4][2], B0[2][2], B1[2][2];
    const char* cA = (const char*)g.A + (size_t)cur.pm * tstep; const char* cB = (const char*)g.Bt + (size_t)cur.pn * tstep;
    S.a_ready(cur);
    if constexpr (SP2) {
        PG8_STAGE(PG8_SB(0, 0), cB, voffB); PG8_STAGE(PG8_SB(0, 1), cB + hstep, voffB); PG8_STAGE(PG8_SA(0, 0), cA, voffA); PG8_STAGE(PG8_SA(0, 1), cA + hstep, voffA);
        if (wr == 1) PG8_BAR;
        PG8_WAIT_V(2); PG8_BAR;
        PG8_STAGE(PG8_SB(1, 0), cB + kstep, voffB); PG8_STAGE(PG8_SA(1, 0), cA + kstep, voffA); PG8_STAGE(PG8_SB(1, 1), cB + hstep + kstep, voffB);
        PG8_WAIT_V(6); PG8_BAR;
    } else {
        PG8_STAGE(PG8_SB(0, 0), cB, voffB); PG8_STAGE(PG8_SA(0, 0), cA, voffA); PG8_STAGE(PG8_SB(0, 1), cB + hstep, voffB); PG8_STAGE(PG8_SA(0, 1), cA + hstep, voffA);
        if (wr == 1) PG8_BAR;
        PG8_WAIT_V(4); PG8_BAR;
        PG8_STAGE(PG8_SB(1, 0), cB + kstep, voffB); PG8_STAGE(PG8_SA(1, 0), cA + kstep, voffA); PG8_STAGE(PG8_SB(1, 1), cB + hstep + kstep, voffB);
        PG8_WAIT_V(6); PG8_BAR;
    }
    for (;;) {
        const bool has_next = S.next(ui + 1, nxt);
        const char* nA = has_next ? (const char*)g.A + (size_t)nxt.pm * tstep : cA; const char* nB = has_next ? (const char*)g.Bt + (size_t)nxt.pn * tstep : cB;
        for (int t = 0; t < nt; t += 2) {
            const bool last = (t == nt - 2);
            const char* a1 = cA + (size_t)(t + 1) * kstep;
            const char* a2 = last ? nA : cA + (size_t)(t + 2) * kstep; const char* b2 = last ? nB : cB + (size_t)(t + 2) * kstep;
            const char* a3 = a2 + kstep; const char* b3 = b2 + kstep;
            if (last && has_next) S.a_ready(nxt);
            if constexpr (SP2) {
            PG8_LDB(B0, 0, 0); PG8_LDB(B1, 0, 1); PG8_SCHED; PG8_LDA(At, 0, 0); PG8_STAGE(PG8_SA(1, 1), a1 + hstep, voffA);
            PG8_WAIT_V(8); PG8_WAIT_L(0); PG8_BAR; PG8_MMA(0, 0, At, B0); PG8_MMA(0, 1, At, B1); PG8_BAR; PG8_SCHED;
            PG8_LDA(At, 0, 1); PG8_STAGE(PG8_SB(0, 0), b2, voffB); PG8_STAGE(PG8_SB(0, 1), b2 + hstep, voffB); PG8_STAGE(PG8_SA(0, 0), a2, voffA);
            PG8_WAIT_V(8); PG8_WAIT_L(0); PG8_BAR; PG8_MMA(1, 0, At, B0); PG8_MMA(1, 1, At, B1); PG8_BAR; PG8_SCHED;
            PG8_LDB(B0, 1, 0); PG8_LDB(B1, 1, 1); PG8_SCHED; PG8_LDA(At, 1, 0); PG8_STAGE(PG8_SA(0, 1), a2 + hstep, voffA);
            PG8_WAIT_V(8); PG8_WAIT_L(0); PG8_BAR; PG8_MMA(0, 0, At, B0); PG8_MMA(0, 1, At, B1); PG8_BAR; PG8_SCHED;
            PG8_LDA(At, 1, 1); PG8_STAGE(PG8_SB(1, 0), b3, voffB); PG8_STAGE(PG8_SB(1, 1), b3 + hstep, voffB); PG8_STAGE(PG8_SA(1, 0), a3, voffA);
            PG8_WAIT_V(8); PG8_WAIT_L(0); PG8_BAR; PG8_MMA(1, 0, At, B0); PG8_MMA(1, 1, At, B1); PG8_BAR; PG8_SCHED;
            } else {
            PG8_LDB(B0, 0, 0); PG8_SCHED; PG8_LDA(At, 0, 0); PG8_STAGE(PG8_SA(1, 1), a1 + hstep, voffA);
            PG8_WAIT_L(8); PG8_BAR; PG8_WAIT_L(0); PG8_MMA(0, 0, At, B0); PG8_BAR; PG8_SCHED;
            PG8_LDB(B1, 0, 1); PG8_STAGE(PG8_SB(0, 0), b2, voffB);
            PG8_BAR; PG8_WAIT_L(0); PG8_MMA(0, 1, At, B1); PG8_BAR;
            PG8_LDA(At, 0, 1); PG8_STAGE(PG8_SA(0, 0), a2, voffA);
            PG8_BAR; PG8_WAIT_L(0); PG8_MMA(1, 0, At, B0); PG8_BAR; PG8_SCHED;
            PG8_STAGE(PG8_SB(0, 1), b2 + hstep, voffB);
            PG8_WAIT_V(6); PG8_BAR; PG8_MMA(1, 1, At, B1); PG8_BAR;
            PG8_LDB(B0, 1, 0); PG8_SCHED; PG8_LDA(At, 1, 0); PG8_STAGE(PG8_SA(0, 1), a2 + hstep, voffA);
            PG8_WAIT_L(8); PG8_BAR; PG8_WAIT_L(0); PG8_MMA(0, 0, At, B0); PG8_BAR; PG8_SCHED;
            PG8_LDB(B1, 1, 1); PG8_STAGE(PG8_SB(1, 0), b3, voffB);
            PG8_BAR; PG8_WAIT_L(0); PG8_MMA(0, 1, At, B1); PG8_BAR;
            PG8_LDA(At, 1, 1); PG8_STAGE(PG8_SA(1, 0), a3, voffA);
            PG8_BAR; PG8_WAIT_L(0); PG8_MMA(1, 0, At, B0); PG8_BAR; PG8_SCHED;
            PG8_STAGE(PG8_SB(1, 1), b3 + hstep, voffB);
            PG8_WAIT_V(6); PG8_BAR; PG8_MMA(1, 1, At, B1); PG8_BAR;
            }
        }
        if constexpr (ALIGN_EPI) { if (wr == 0) PG8_BAR; }
        if constexpr (!Epi::AFTER_DRAIN) { E(acc, cur, wr, wc, fr, fq); S.done(cur); }
        if (!has_next) break;
#pragma unroll
        for (int a = 0; a < 2; ++a)
#pragma unroll
            for (int b = 0; b < 2; ++b)
#pragma unroll
                for (int m = 0; m < 4; ++m)
#pragma unroll
                    for (int n = 0; n < 2; ++n) acc[a][b][m][n] = (f32x4){0.f, 0.f, 0.f, 0.f};
        cur = nxt; cA = nA; cB = nB; ++ui;
        if constexpr (ALIGN_EPI) { if (wr == 1) PG8_BAR; }
    }
    PG8_WAIT_V(0);
    if constexpr (!ALIGN_EPI) { if (wr == 0) PG8_BAR; }
    PG8_BAR;
    if constexpr (Epi::AFTER_DRAIN) { E.fused(acc, cur, wr, wc, fr, fq, lds, wid, lane); S.done(cur); }
#undef PG8_SA
#undef PG8_SB
#undef PG8_STAGE
#undef PG8_LDA
#undef PG8_LDB
#undef PG8_MMA
#undef PG8_WAIT_V
#undef PG8_WAIT_L
#undef PG8_BAR
#undef PG8_SCHED
}
}
#define GAS __attribute__((address_space(1)))
#define LAS __attribute__((address_space(3)))
typedef unsigned short bf16;
typedef unsigned v4u __attribute__((ext_vector_type(4)));
typedef float f32x4 __attribute__((ext_vector_type(4)));
typedef short bf16x8 __attribute__((ext_vector_type(8)));
typedef GAS unsigned gu32;
typedef GAS unsigned long long gu64;
#define RLX_AGENT __ATOMIC_RELAXED, __HIP_MEMORY_SCOPE_AGENT
#define LDS_WAIT() asm volatile("s_waitcnt lgkmcnt(0)" ::: "memory")
#define VM_WAIT() asm volatile("s_waitcnt vmcnt(0)" ::: "memory")
__device__ __forceinline__ unsigned long long rt() { return __builtin_amdgcn_s_memrealtime(); }
__device__ __forceinline__ unsigned f2bf(float f) { unsigned u = __builtin_bit_cast(unsigned, f); return (u + 0x7fffu + ((u >> 16) & 1u)) >> 16; }
__device__ __forceinline__ unsigned pk2(float lo, float hi) { return f2bf(lo) | (f2bf(hi) << 16); }
#define XB_TMO      128
#define XB_XCNT(j)  (256  + 64 * (j))
#define XB_XSUB(j)  (1280 + 64 * (j))
#define XB_XGEN(j)  (2304 + 64 * (j))
#define XB_TOP      3328
#define XB_TOPGEN   3392
#define XCD_BAR_WORDS 3456
#define XB_SPIN_CAP (1u << 24)

__device__ __forceinline__ unsigned xb_ld(unsigned* p)              { return __hip_atomic_load(p, __ATOMIC_RELAXED, __HIP_MEMORY_SCOPE_AGENT); }
__device__ __forceinline__ unsigned xb_add(unsigned* p, unsigned v) { return __hip_atomic_fetch_add(p, v, __ATOMIC_RELAXED, __HIP_MEMORY_SCOPE_AGENT); }
__device__ __forceinline__ unsigned xb_xcc_id() { return (unsigned)__builtin_amdgcn_s_getreg((3 << 11) | 20) & 0xFu; }
#define XB_SPIN(cond, bar) do { unsigned _sp = 0; while (cond) { __builtin_amdgcn_s_sleep(1); \
    if ((++_sp & 255u) == 0u) { if (xb_ld(&(bar)[XB_TMO])) break; if (_sp > XB_SPIN_CAP) { atomicAdd(&(bar)[XB_TMO], 1u); break; } } } } while (0)

struct XcdBarrier {
    unsigned* bar; unsigned x;
    volatile LAS unsigned* st;
};

__device__ __forceinline__ XcdBarrier xcd_barrier_post(unsigned* bar, volatile LAS unsigned* st) {
    XcdBarrier b; b.bar = bar; b.x = xb_xcc_id(); b.st = st;
    if (threadIdx.x == 0) (void)xb_add(&bar[XB_XCNT(b.x)], 1u);
    return b;
}
__device__ __forceinline__ void xcd_barrier_complete(unsigned* bar, unsigned x, unsigned& nloc, unsigned& nx) {
    const unsigned G = gridDim.x * gridDim.y * gridDim.z;
    unsigned sum, cnt, mine, sp = 0u;
    for (;;) {
        sum = 0u; cnt = 0u; mine = 0u;
#pragma unroll
        for (unsigned j = 0; j < 16; ++j) { const unsigned c = xb_ld(&bar[XB_XCNT(j)]); sum += c; cnt += (c > 0u) ? 1u : 0u; mine = (j == x) ? c : mine; }
        if (sum == G) break;
        __builtin_amdgcn_s_sleep(1);
        if ((++sp & 255u) == 0u) { if (xb_ld(&bar[XB_TMO])) break; if (sp > XB_SPIN_CAP) { atomicAdd(&bar[XB_TMO], 1u); break; } }
    }
    nloc = mine > 0u ? mine : 1u; nx = cnt > 0u ? cnt : 1u;
}

__device__ __forceinline__ void xcd_barrier(const XcdBarrier& b) {
    asm volatile("s_waitcnt vmcnt(0)" ::: "memory");
    __syncthreads();
    if (threadIdx.x == 0) {
        unsigned* bar = b.bar;
        __builtin_amdgcn_s_waitcnt(0);
        unsigned nloc = b.st[0], nx = b.st[1];
        if (nloc == 0u) { xcd_barrier_complete(bar, b.x, nloc, nx); b.st[0] = nloc; b.st[1] = nx; }
        const unsigned old = xb_add(&bar[XB_XSUB(b.x)], 1u);
        const unsigned gen = old / nloc;
        if (old + 1u == (gen + 1u) * nloc) {
            __builtin_amdgcn_fence(__ATOMIC_RELEASE, "agent");
            asm volatile("s_waitcnt vmcnt(0)" ::: "memory");
            const unsigned og = xb_add(&bar[XB_TOP], 1u);
            const unsigned tg = og / nx;
            if (og + 1u == (tg + 1u) * nx) xb_add(&bar[XB_TOPGEN], 1u);
            else XB_SPIN(xb_ld(&bar[XB_TOPGEN]) == tg, bar);
            __builtin_amdgcn_fence(__ATOMIC_ACQUIRE, "agent");
            xb_add(&bar[XB_XGEN(b.x)], 1u);
            asm volatile("s_waitcnt vmcnt(0)" ::: "memory");
        } else {
            XB_SPIN(xb_ld(&bar[XB_XGEN(b.x)]) == gen, bar);
            __builtin_amdgcn_fence(__ATOMIC_ACQUIRE, "agent");
            asm volatile("s_waitcnt vmcnt(0)" ::: "memory");
        }
    }
    __syncthreads();
}
#include <hip/hip_bf16.h>
#include <cmath>
namespace attn_body {
using bf16=__hip_bfloat16;
using bf16x8=__attribute__((ext_vector_type(8)))short;
using s16x4=__attribute__((ext_vector_type(4)))short;
using f32x16=__attribute__((ext_vector_type(16)))float;
using u32x4=__attribute__((ext_vector_type(4)))unsigned;
constexpr int NHEAD=16,D=64,DM=NHEAD*D;
constexpr int NW=8,QBLK=32,QB=QBLK*NW,KVBLK=64;
constexpr int ATTN_PITCH=DM, ATTN_UNIT_ROWS=QB;
__device__ __forceinline__ int crow(int r,int hi){return (r&3)+8*(r>>2)+4*hi;}
#define SBAR() __builtin_amdgcn_sched_barrier(0)
__device__ __forceinline__ void cmask(f32x16&p0,f32x16&p1,int jb,int qrel,int hi){
  const float NEG=-INFINITY; int kb=64*jb+4*hi;
  #pragma unroll
  for(int r=0;r<16;++r){int kv=kb+(r&3)+8*(r>>2); if(kv>qrel)p0[r]=NEG; if(kv+32>qrel)p1[r]=NEG;}
}

constexpr int NSLOT=3, SLOTB=8192;
constexpr int MAXKEYS=2048;
constexpr int LDS_K=0, LDS_V=NSLOT*SLOTB, LDS_WS=2*NSLOT*SLOTB, LDS_OST=LDS_WS+NW*64*4, LDS_BIAS=LDS_OST+NW*4096, LDS_BYTES=LDS_BIAS+MAXKEYS*4;
constexpr float C2=0.125f*1.4426950408889634f;
__device__ __forceinline__ void glds16(const void*gsrc,unsigned lds_dst){unsigned keep;
  asm volatile("s_mov_b32 %0, m0\n\ts_mov_b32 m0, %2\n\ts_nop 0\n\tglobal_load_lds_dwordx4 %1, off\n\ts_mov_b32 m0, %0":"=&s"(keep):"v"(gsrc),"s"(lds_dst):"memory");}
__device__ __forceinline__ float max3f(float a,float b,float c){float r;asm("v_max3_f32 %0, %1, %2, %3":"=v"(r):"v"(a),"v"(b),"v"(c));return r;}
__device__ __forceinline__ float max2f(float a,float b){float r;asm("v_max_f32_e32 %0, %1, %2":"=v"(r):"v"(a),"v"(b));return r;}
__device__ __forceinline__ float fadd_s(float a,float b){float r;asm("v_add_f32_e32 %0, %1, %2":"=v"(r):"v"(a),"v"(b));return r;}
__device__ __forceinline__ float fsub_s(float a,float b){float r;asm("v_sub_f32_e32 %0, %1, %2":"=v"(r):"v"(a),"v"(b));return r;}
typedef float f32x2_t __attribute__((ext_vector_type(2))); typedef __bf16 bf16x2_t __attribute__((ext_vector_type(2)));
__device__ __forceinline__ unsigned cvtpk_s(float lo,float hi){f32x2_t v={lo,hi};bf16x2_t b=__builtin_convertvector(v,bf16x2_t);return __builtin_bit_cast(unsigned,b);}
#define WAIT_BAR(N) asm volatile("s_waitcnt vmcnt(" #N ") lgkmcnt(0)\n\ts_barrier":::"memory")

__device__ __forceinline__ void qkt(f32x16&p0,f32x16&p1,const char*Kslot,const bf16x8*qr,bf16x8 kxa,bf16x8 kxb,bf16x8 qx,int r32,int hi){
  const f32x16 zero16=f32x16{};
  const char*kb=Kslot+hi*1024+r32*16;
  #pragma unroll
  for(int d0=0;d0<4;++d0){
    const bf16x8 b0=*reinterpret_cast<const bf16x8*>(kb+d0*2048);
    const bf16x8 b1=*reinterpret_cast<const bf16x8*>(kb+d0*2048+512);
    if(d0==0){p0=__builtin_amdgcn_mfma_f32_32x32x16_bf16(b0,qr[0],zero16,0,0,0);p1=__builtin_amdgcn_mfma_f32_32x32x16_bf16(b1,qr[0],zero16,0,0,0);}
    else{p0=__builtin_amdgcn_mfma_f32_32x32x16_bf16(b0,qr[d0],p0,0,0,0);p1=__builtin_amdgcn_mfma_f32_32x32x16_bf16(b1,qr[d0],p1,0,0,0);}}
  p0=__builtin_amdgcn_mfma_f32_32x32x16_bf16(kxa,qx,p0,0,0,0);p1=__builtin_amdgcn_mfma_f32_32x32x16_bf16(kxb,qx,p1,0,0,0);
}
typedef __attribute__((address_space(3))) const char* lds_cptr;
typedef short v4i16_t __attribute__((ext_vector_type(4)));
__device__ __forceinline__ void kload8(bf16x8*kf,lds_cptr kp){
  kf[0]=*(const __attribute__((address_space(3))) bf16x8*)(kp);      kf[1]=*(const __attribute__((address_space(3))) bf16x8*)(kp+512);
  kf[2]=*(const __attribute__((address_space(3))) bf16x8*)(kp+2048); kf[3]=*(const __attribute__((address_space(3))) bf16x8*)(kp+2560);
  kf[4]=*(const __attribute__((address_space(3))) bf16x8*)(kp+4096); kf[5]=*(const __attribute__((address_space(3))) bf16x8*)(kp+4608);
  kf[6]=*(const __attribute__((address_space(3))) bf16x8*)(kp+6144); kf[7]=*(const __attribute__((address_space(3))) bf16x8*)(kp+6656);
}
__device__ __forceinline__ void kload2(bf16x8*kf,lds_cptr kp,int j){ kf[2*j]=*(const __attribute__((address_space(3))) bf16x8*)(kp+j*2048); kf[2*j+1]=*(const __attribute__((address_space(3))) bf16x8*)(kp+j*2048+512); }
__device__ __forceinline__ s16x4 vtr(lds_cptr p){ return __builtin_bit_cast(s16x4,__builtin_amdgcn_ds_read_tr16_b64_v4i16((__attribute__((address_space(3))) v4i16_t*)p)); }
__device__ __forceinline__ float rowmax(const f32x16&p0,const f32x16&p1){
  float a=max3f(p0[0],p0[1],p1[0]),b=max3f(p0[2],p0[3],p1[1]);a=max3f(a,p1[2],p1[3]);
  #pragma unroll
  for(int r=4;r<16;r+=4){a=max3f(a,p0[r],p0[r+1]);b=max3f(b,p0[r+2],p0[r+3]);a=max3f(a,p1[r],p1[r+1]);b=max3f(b,p1[r+2],p1[r+3]);}
  const float m=max2f(a,b);
  auto rr=__builtin_amdgcn_permlane32_swap(__float_as_uint(m),__float_as_uint(m),false,false);
  return max2f(__uint_as_float(rr[0]),__uint_as_float(rr[1]));
}
__device__ __forceinline__ void pv(f32x16*o,int vb,bf16x8 pa0,bf16x8 pa1,bf16x8 pa2,bf16x8 pa3){
  #pragma unroll
  for(int d0=0;d0<2;++d0){s16x4 lo[4],hi[4];
    #pragma unroll
    for(int ks=0;ks<4;++ks){
      asm volatile("ds_read_b64_tr_b16 %0,%1 offset:%c2":"=&v"(lo[ks]):"v"(vb),"i"(d0*4096+ks*1024):"memory");
      asm volatile("ds_read_b64_tr_b16 %0,%1 offset:%c2":"=&v"(hi[ks]):"v"(vb),"i"(d0*4096+ks*1024+512):"memory");}
    asm volatile("s_waitcnt lgkmcnt(0)":::"memory");SBAR();
    #define PK(k) (bf16x8){lo[k][0],lo[k][1],lo[k][2],lo[k][3],hi[k][0],hi[k][1],hi[k][2],hi[k][3]}
    o[d0]=__builtin_amdgcn_mfma_f32_32x32x16_bf16(pa0,PK(0),o[d0],0,0,0);
    o[d0]=__builtin_amdgcn_mfma_f32_32x32x16_bf16(pa1,PK(1),o[d0],0,0,0);
    o[d0]=__builtin_amdgcn_mfma_f32_32x32x16_bf16(pa2,PK(2),o[d0],0,0,0);
    o[d0]=__builtin_amdgcn_mfma_f32_32x32x16_bf16(pa3,PK(3),o[d0],0,0,0);
    #undef PK
  }
}

#ifndef ATTN_STORE16
#define ATTN_STORE16(p,v) (*(u32x4*)(p)=(v))
#endif
__device__ __forceinline__ void split3(float c,unsigned&h,unsigned&m,unsigned&l){ const unsigned cb=__float_as_uint(c); h=cb&0xffff0000u; const float r1=c-__uint_as_float(h); const unsigned r1b=__float_as_uint(r1); m=r1b&0xffff0000u; const float r2=r1-__uint_as_float(m); l=__float_as_uint(r2)&0xffff0000u; }
__device__ __forceinline__ bf16x8 kx_frag(float bias,int hi){ unsigned h,m,l; split3(bias,h,m,l); u32x4 w; w.x=hi?0u:((h>>16)|m); w.y=hi?0u:((l>>16)|0x3f800000u); w.z=hi?0u:0x3f803f80u; w.w=0u; return __builtin_bit_cast(bf16x8,w); }
__device__ __forceinline__ bf16x8 qx_frag(float nref,int hi){ unsigned h,m,l; split3(nref,h,m,l); u32x4 w; w.x=hi?0u:0x3f803f80u; w.y=hi?0u:(0x3f80u|h); w.z=hi?0u:((m>>16)|l); w.w=0u; return __builtin_bit_cast(bf16x8,w); }
template<int THRL> __device__ __forceinline__ void attn_unit(int q0,const bf16*Qw,const bf16*__restrict__ Kh,const bf16*__restrict__ Vh,const bf16*Gw,bf16*Ow,const float*__restrict__ biasg,int nbias,bool st_ok,char*shm){
  int tid_=threadIdx.x; asm volatile("":"+v"(tid_));
  const int tid=tid_,lane=tid&63,r32=lane&31,hi=lane>>5; const int wid=__builtin_amdgcn_readfirstlane(tid>>6);
  float*biasL=(float*)(shm+LDS_BIAS);
  for(int i=tid;i<nbias;i+=NW*64)biasL[i]=biasg[i];
  const unsigned lds0=(unsigned)(uintptr_t)shm;
  float*wsf=(float*)(shm+LDS_WS)+wid*64;
  const bf16*ksrc=Kh+(long)lane*DM+wid*8;
  const bf16*vsrc=Vh+(long)(16*(wid&3)+(lane>>2))*DM+(wid>>2)*32+(lane&3)*8;
  const unsigned kdst=lds0+LDS_K+wid*1024, vdst=lds0+LDS_V+wid*1024;
  #define DMA_K(t,slot) glds16(ksrc+(long)(t)*KVBLK*DM,(unsigned)__builtin_amdgcn_readfirstlane(kdst+(slot)))
  #define DMA_V(t,slot) glds16(vsrc+(long)(t)*KVBLK*DM,(unsigned)__builtin_amdgcn_readfirstlane(vdst+(slot)))
  const int vb0=(int)(lds0+LDS_V)+((lane>>4)&1)*32+(lane&3)*8+(4*hi+((lane&15)>>2))*64;
  const char*Kbase=shm+LDS_K; bf16x8 kf[8];
  const lds_cptr shm3=(lds_cptr)shm; const lds_cptr kp0=shm3+LDS_K+hi*1024+r32*16; const lds_cptr vp0=shm3+LDS_V+((lane>>4)&1)*32+(lane&3)*8+(4*hi+((lane&15)>>2))*64;
  const int NT=(q0+QB)/KVBLK;
  if(!st_ok){
    int sc_=0,sn_=SLOTB;
    #define IROT() do{sc_=sn_;sn_=(sn_==(NSLOT-1)*SLOTB)?0:sn_+SLOTB;}while(0)
    #define IDLE(t,GK,GV) do{ if(GK){DMA_K((t)+3,sc_);} if(GV){DMA_V((t)+1,sn_);} }while(0)
    #define IENDW(tt) do{ if((tt)+3<NT){WAIT_BAR(2);} else if((tt)+2<NT){WAIT_BAR(1);} else {WAIT_BAR(0);} }while(0)
    DMA_K(0,0);DMA_V(0,0);DMA_K(1,SLOTB);DMA_K(2,2*SLOTB); WAIT_BAR(3);
    WAIT_BAR(0); DMA_K(3,0);DMA_V(1,SLOTB); IROT(); WAIT_BAR(2);
    int ti=1;
    for(;ti+5<NT;ti+=2){ IDLE(ti,true,true); WAIT_BAR(2); IROT(); IDLE(ti+1,true,true); WAIT_BAR(2); IROT(); }
    for(;ti+1<NT;ti+=2){ IDLE(ti,(ti+3<NT),(ti+1<NT)); IENDW(ti); IROT(); IDLE(ti+1,(ti+4<NT),(ti+2<NT)); IENDW(ti+1); IROT(); }
    asm volatile("s_waitcnt vmcnt(0) lgkmcnt(0)\n\ts_barrier":::"memory");
    #undef IROT
    #undef IDLE
    #undef IENDW
    return;
  }
  DMA_K(0,0);DMA_V(0,0);DMA_K(1,SLOTB);
  bf16x8 qr[4];
  #pragma unroll
  for(int d0=0;d0<4;++d0)qr[d0]=*reinterpret_cast<const bf16x8*>(&Qw[(long)r32*DM+d0*16+hi*8]);
  u32x4 gpre[4];
  #pragma unroll
  for(int i=0;i<4;++i)gpre[i]=st_ok?*(const u32x4*)(Gw+(long)(i*8+(lane>>3))*DM+(lane&7)*8):(u32x4){0u,0u,0u,0u};
  float mhat=0.f,l_reg=0.f;f32x16 o[2];o[0]=f32x16{};o[1]=f32x16{}; bf16x8 qx=qx_frag(0.f,hi); const f32x16 zero16=f32x16{};
  const int qrel=wid*QBLK+r32;
  #define CMASK(P0,P1,t) do{int jb_=(t)-(NT-4); if(jb_>=0)cmask(P0,P1,jb_,qrel,hi);}while(0)
  bool resc=false;
  #define START(P0,P1) do{ const float rm=rowmax(P0,P1); resc=false; \
    { const float dl=rm; mhat=fadd_s(mhat,dl); \
      _Pragma("unroll") for(int r=0;r<16;++r){P0[r]=fsub_s(P0[r],dl);P1[r]=fsub_s(P1[r],dl);} \
      qx=qx_frag(-mhat,hi); } \
    _Pragma("unroll") for(int r=0;r<16;++r)P0[r]=__builtin_amdgcn_exp2f(P0[r]); }while(0)
  #define RESC() do{ if(resc){ asm volatile("s_waitcnt lgkmcnt(0)":::"memory"); \
      _Pragma("unroll") for(int d_=0;d_<2;++d_) _Pragma("unroll") for(int r=0;r<16;++r)o[d_][r]*=wsf[crow(r,hi)]; } }while(0)
  f32x16 pA0,pA1,pB0,pB1;
  int sl_prev=0,sl_cur=0,sl_next=SLOTB;
  #define ROT() do{sl_prev=sl_cur;sl_cur=sl_next;sl_next=(sl_next==(NSLOT-1)*SLOTB)?0:sl_next+SLOTB;}while(0)
  DMA_K(2,2*SLOTB);
  WAIT_BAR(3);
  qkt(pA0,pA1,Kbase,qr,kx_frag(biasL[r32],hi),kx_frag(biasL[32+r32],hi),qx,r32,hi);asm volatile("s_nop 15\n\ts_nop 7":"+v"(pA0),"+v"(pA1));CMASK(pA0,pA1,0);
  START(pA0,pA1);
  _Pragma("unroll") for(int r=0;r<16;++r)pA1[r]=__builtin_amdgcn_exp2f(pA1[r]);
  WAIT_BAR(0);
  DMA_K(3,0);DMA_V(1,SLOTB);
  ROT();
  kload8(kf,kp0+sl_cur);
  WAIT_BAR(2);
  s16x4 vlo[8],vhi[8]; u32x4 pw0,pw1,pw2,pw3;
  #define PKW(P,B) cvtpk_s(P[B],P[B+1])
  #define PAF(k) __builtin_bit_cast(bf16x8,pw##k)
  #define VFR(i) (bf16x8){vlo[i][0],vlo[i][1],vlo[i][2],vlo[i][3],vhi[i][0],vhi[i][1],vhi[i][2],vhi[i][3]}
  #define PIN(x) asm volatile("":"+v"(x))
  #define MX3(a,b,c) __builtin_fmaxf(__builtin_fmaxf((a),(b)),(c))
  #define GAPA(MF,A0,A1,A2,A3,W0,W1,PW) do{ MF; sacc+=A0; sacc+=A1; sacc+=A2; sacc+=A3; PIN(sacc); W0; W1; PIN(PW); SBAR(); }while(0)
  #define EX(v) __builtin_amdgcn_exp2f(v)
  #define GAPB(MF,X,B) do{ MF; X[B]=EX(X[B]); X[B+1]=EX(X[B+1]); X[B+2]=EX(X[B+2]); X[B+3]=EX(X[B+3]); PIN(X); SBAR(); }while(0)
  #define VRD(i) do{ vlo[i]=vtr(vp_+(((i)>>2)*4096+((i)&3)*1024)); vhi[i]=vtr(vp_+(((i)>>2)*4096+((i)&3)*1024+512)); }while(0)
  #define KRD(G,j) do{ if(G){ kload2(kf,kp0+sl_next,j); SBAR(); } }while(0)
  #define STEP(C0,C1,P0,P1,t,GK,GV,GL) do{ SBAR(); \
    const lds_cptr vp_=vp0+sl_prev; const float bia_=biasL[(t)*KVBLK+r32], bib_=biasL[(t)*KVBLK+32+r32]; \
    VRD(0); SBAR(); float sacc=(P0[0]+P0[1]); \
    GAPA(C0=__builtin_amdgcn_mfma_f32_32x32x16_bf16(kf[0],qr[0],zero16,0,0,0), P0[2],P0[3],P0[4],P0[5],     pw0[0]=PKW(P0,0), pw0[1]=PKW(P0,2), pw0); \
    VRD(4); SBAR(); GAPA(C1=__builtin_amdgcn_mfma_f32_32x32x16_bf16(kf[1],qr[0],zero16,0,0,0), P0[6],P0[7],P0[8],P0[9],     pw0[2]=PKW(P0,4), pw0[3]=PKW(P0,6), pw0); \
    VRD(1); SBAR(); GAPA(C0=__builtin_amdgcn_mfma_f32_32x32x16_bf16(kf[2],qr[1],C0,0,0,0),   P0[10],P0[11],P0[12],P0[13], pw1[0]=PKW(P0,8), pw1[1]=PKW(P0,10), pw1); \
    VRD(5); SBAR(); GAPA(C1=__builtin_amdgcn_mfma_f32_32x32x16_bf16(kf[3],qr[1],C1,0,0,0),   P0[14],P0[15],P1[0],P1[1],   pw1[2]=PKW(P0,12),pw1[3]=PKW(P0,14), pw1); \
    VRD(2); SBAR(); GAPA(C0=__builtin_amdgcn_mfma_f32_32x32x16_bf16(kf[4],qr[2],C0,0,0,0),   P1[2],P1[3],P1[4],P1[5],     pw2[0]=PKW(P1,0), pw2[1]=PKW(P1,2), pw2); \
    VRD(6); SBAR(); GAPA(C1=__builtin_amdgcn_mfma_f32_32x32x16_bf16(kf[5],qr[2],C1,0,0,0),   P1[6],P1[7],P1[8],P1[9],     pw2[2]=PKW(P1,4), pw2[3]=PKW(P1,6), pw2); \
    VRD(3); SBAR(); GAPA(C0=__builtin_amdgcn_mfma_f32_32x32x16_bf16(kf[6],qr[3],C0,0,0,0),   P1[10],P1[11],P1[12],P1[13], pw3[0]=PKW(P1,8), pw3[1]=PKW(P1,10), pw3); \
    VRD(7); SBAR(); GAPA(C1=__builtin_amdgcn_mfma_f32_32x32x16_bf16(kf[7],qr[3],C1,0,0,0),   P1[14],P1[15],0.f,0.f,       pw3[2]=PKW(P1,12),pw3[3]=PKW(P1,14), pw3); \
    { const bf16x8 kxa_=kx_frag(bia_,hi), kxb_=kx_frag(bib_,hi); C0=__builtin_amdgcn_mfma_f32_32x32x16_bf16(kxa_,qx,C0,0,0,0); C1=__builtin_amdgcn_mfma_f32_32x32x16_bf16(kxb_,qx,C1,0,0,0); } SBAR(); \
    l_reg+=sacc; \
    if(GK){DMA_K((t)+3,sl_cur);} if(GV){DMA_V((t)+1,sl_next);} \
    CMASK(C0,C1,t); \
    { float a=MX3(C0[0],C0[1],C1[0]),b=MX3(C0[2],C0[3],C1[1]); a=MX3(a,C1[2],C1[3]); \
      _Pragma("unroll") for(int r=4;r<16;r+=4){a=MX3(a,C0[r],C0[r+1]);b=MX3(b,C0[r+2],C0[r+3]);a=MX3(a,C1[r],C1[r+1]);b=MX3(b,C1[r+2],C1[r+3]);} \
      float rm=__builtin_fmaxf(a,b); { auto rr=__builtin_amdgcn_permlane32_swap(__float_as_uint(rm),__float_as_uint(rm),false,false); rm=__builtin_fmaxf(__uint_as_float(rr[0]),__uint_as_float(rr[1])); } \
      resc=false; \
      if(__builtin_expect(__any(rm>(float)THRL),0)){ const float dl=__builtin_fmaxf(rm,0.f); mhat+=dl; \
        _Pragma("unroll") for(int r=0;r<16;++r){C0[r]-=dl;C1[r]-=dl;} \
        qx=qx_frag(-mhat,hi); \
        const float f=__builtin_amdgcn_exp2f(-dl); l_reg*=f; if(hi==0)wsf[r32]=f; resc=true; } } \
    SBAR(); \
    GAPB(o[0]=__builtin_amdgcn_mfma_f32_32x32x16_bf16(PAF(0),VFR(0),o[0],0,0,0), C0,0); \
    GAPB(o[1]=__builtin_amdgcn_mfma_f32_32x32x16_bf16(PAF(0),VFR(4),o[1],0,0,0), C0,4); \
    KRD(GL,0); GAPB(o[0]=__builtin_amdgcn_mfma_f32_32x32x16_bf16(PAF(1),VFR(1),o[0],0,0,0), C0,8); \
    KRD(GL,1); GAPB(o[1]=__builtin_amdgcn_mfma_f32_32x32x16_bf16(PAF(1),VFR(5),o[1],0,0,0), C0,12); \
    KRD(GL,2); GAPB(o[0]=__builtin_amdgcn_mfma_f32_32x32x16_bf16(PAF(2),VFR(2),o[0],0,0,0), C1,0); \
    KRD(GL,3); GAPB(o[1]=__builtin_amdgcn_mfma_f32_32x32x16_bf16(PAF(2),VFR(6),o[1],0,0,0), C1,4); \
    GAPB(o[0]=__builtin_amdgcn_mfma_f32_32x32x16_bf16(PAF(3),VFR(3),o[0],0,0,0), C1,8); \
    GAPB(o[1]=__builtin_amdgcn_mfma_f32_32x32x16_bf16(PAF(3),VFR(7),o[1],0,0,0), C1,12); \
    }while(0)
  int t=1;
  #undef CMASK
  #define CMASK(P0,P1,t) do{}while(0)
  for(;t+5<NT;t+=2){
    STEP(pB0,pB1,pA0,pA1,t,true,true,true);     WAIT_BAR(2); RESC(); ROT();
    STEP(pA0,pA1,pB0,pB1,t+1,true,true,true);   WAIT_BAR(2); RESC(); ROT();
  }
  #undef CMASK
  #define CMASK(P0,P1,t) do{int jb_=(t)-(NT-4); if(jb_>=0)cmask(P0,P1,jb_,qrel,hi);}while(0)
  #define ENDW(tt) do{ if((tt)+3<NT){WAIT_BAR(2);} else if((tt)+2<NT){WAIT_BAR(1);} else {WAIT_BAR(0);} }while(0)
  for(;t+1<NT;t+=2){
    STEP(pB0,pB1,pA0,pA1,t,(t+3<NT),(t+1<NT),(t+1<NT));       ENDW(t);   RESC(); ROT();
    STEP(pA0,pA1,pB0,pB1,t+1,(t+4<NT),(t+2<NT),(t+2<NT));     ENDW(t+1); RESC(); ROT();
  }
  STEP(pB0,pB1,pA0,pA1,NT-1,false,false,false); RESC();
  { float sacc=pB0[0]+pB0[1]; _Pragma("unroll") for(int r=2;r<16;++r)sacc+=pB0[r]; _Pragma("unroll") for(int r=0;r<16;++r)sacc+=pB1[r]; l_reg+=sacc;
    pw0=(u32x4){PKW(pB0,0),PKW(pB0,2),PKW(pB0,4),PKW(pB0,6)};pw1=(u32x4){PKW(pB0,8),PKW(pB0,10),PKW(pB0,12),PKW(pB0,14)};pw2=(u32x4){PKW(pB1,0),PKW(pB1,2),PKW(pB1,4),PKW(pB1,6)};pw3=(u32x4){PKW(pB1,8),PKW(pB1,10),PKW(pB1,12),PKW(pB1,14)};
    SBAR(); pv(o,vb0+sl_cur,PAF(0),PAF(1),PAF(2),PAF(3)); }
  #undef PKW
  #undef PAF
  #undef VFR
  #undef PIN
  #undef MX3
  #undef GAPA
  #undef GAPB
  #undef EX
  #undef VRD
  #undef KRD
  #undef STEP
  #undef ENDW
  {auto rr=__builtin_amdgcn_permlane32_swap(__float_as_uint(l_reg),__float_as_uint(l_reg),false,false);l_reg=__uint_as_float(rr[0])+__uint_as_float(rr[1]);}
  if(hi==0)wsf[32+r32]=l_reg;asm volatile("s_waitcnt lgkmcnt(0)":::"memory");
  float rli[16];
  #pragma unroll
  for(int r=0;r<16;++r)rli[r]=__builtin_amdgcn_rcpf(wsf[32+crow(r,hi)]);
  { bf16*stg=(bf16*)(shm+LDS_OST)+wid*2048;
    #pragma unroll
    for(int r=0;r<16;++r){const int orow=crow(r,hi);
      #pragma unroll
      for(int d0=0;d0<2;++d0)stg[orow*64+d0*32+r32]=__float2bfloat16(o[d0][r]*rli[r]);}
    asm volatile("s_waitcnt lgkmcnt(0)":::"memory");
    if(st_ok){
    #pragma unroll
    for(int i=0;i<4;++i){const int row=i*8+(lane>>3),ch=lane&7; const u32x4 v=*(const u32x4*)(stg+row*64+ch*8); const u32x4 g=gpre[i];
      const unsigned vv[4]={v.x,v.y,v.z,v.w},gg[4]={g.x,g.y,g.z,g.w}; unsigned ow[4];
      #pragma unroll
      for(int j=0;j<4;++j){ const float g0=__uint_as_float(gg[j]<<16),g1=__uint_as_float(gg[j]&0xffff0000u),o0=__uint_as_float(vv[j]<<16),o1=__uint_as_float(vv[j]&0xffff0000u);
        ow[j]=cvtpk_s(o0*__builtin_amdgcn_rcpf(1.f+__builtin_amdgcn_exp2f(-1.4426950408889634f*g0)),o1*__builtin_amdgcn_rcpf(1.f+__builtin_amdgcn_exp2f(-1.4426950408889634f*g1))); }
      ATTN_STORE16(Ow+(long)row*DM+ch*8,((u32x4){ow[0],ow[1],ow[2],ow[3]}));} } }
  asm volatile("s_waitcnt lgkmcnt(0)\n\ts_barrier":::"memory");
  #undef DMA_K
  #undef DMA_V
  #undef CMASK
  #undef START
  #undef RESC
  #undef ROT
}
constexpr int ATTN_LDS_BYTES=LDS_BYTES;
#undef SBAR
#undef WAIT_BAR
}
constexpr int NWAVES = 8;
constexpr int DM = 1024;
constexpr int PB = 16, PL = 2048, SBT = 32, SL = 64, PAST = 1024, SKV = PAST + SL;
constexpr int TP = PB * PL, TS = SBT * SL, T = TP + TS;
constexpr int DIN = 2048, CONVD = 3072, NH = 32, NST = 128;
constexpr int IN_DIM = 5152, IN_PAD = 5376, ZXLD = 5120;
constexpr int KVN = 2064, KVPAD = 2304;
constexpr int AH = 16;
constexpr int NEXP = 16384;
constexpr float LN_EPS = 1e-5f, RMS_EPS = 1e-5f;
constexpr float DN_ALPHA = 1.6817928305074290f;
constexpr float ATT_SCALE = 0.125f;

constexpr size_t O_Y = 0, O_PSSM = 35651584, O_PCONV = 44040192, O_PK = 44335104, O_PV = 77889536, O_PLOGF = 111443968,
                 O_SSSM = 111968256, O_SCONV = 128745472, O_SK = 129335296, O_SV = 131432448, O_SLOGF = 133529600, O_END = 133562368;

constexpr size_t MiB = 1u << 20;
constexpr size_t WS_CTL = 0, CTL_ZERO_BYTES = 1 * MiB;
constexpr size_t WS_WIN = 2 * MiB;
constexpr size_t WS_WOUT = 23 * MiB;
constexpr size_t WS_WKV = 31 * MiB;
constexpr size_t WS_WQG = 36 * MiB;
constexpr size_t WS_WO = 44 * MiB;
constexpr size_t WS_WPQ = 48 * MiB;
constexpr size_t WS_SKT = 64 * MiB;
constexpr size_t WS_XB = 66 * MiB;
constexpr size_t WS_R1 = 134 * MiB;
constexpr size_t WS_PQ = WS_R1, WS_QB = WS_R1, WS_GB = WS_R1 + 68 * MiB, WS_OG = WS_R1 + 136 * MiB;
constexpr size_t WS_PART = WS_R1;
constexpr size_t WS_HH = WS_R1 + 136 * MiB;
constexpr size_t WS_DT = 474 * MiB;
constexpr size_t WS_XC = 479 * MiB;
constexpr int SKVP = 1152;
constexpr size_t WS_KP = 479 * MiB, WS_VP = 543 * MiB, WS_KS = 607 * MiB, WS_VS = 679 * MiB, WS_LOGF = 751 * MiB, WS_BIASP = 754 * MiB, WS_BIASS = 757 * MiB, WS_KVEND = 760 * MiB;
constexpr size_t WS_IMG = WS_XC;
constexpr int SSD_IMG = 49152;
constexpr size_t WS_Y = 683 * MiB;
constexpr size_t WS_MIX = 819 * MiB;
constexpr size_t WS_XT = WS_MIX;
constexpr size_t WS_EIDX = 955 * MiB;
constexpr size_t WS_GATE = 972 * MiB;
constexpr size_t WS_T8 = 989 * MiB;
constexpr size_t WS_TSC = 1021 * MiB;
constexpr size_t WS_XQ = 1022 * MiB;
constexpr size_t WS_SX = 1056 * MiB;
constexpr size_t WS_T8B = 1057 * MiB;
constexpr size_t WS_TSCB = 1089 * MiB;
constexpr size_t WS_END = 1090 * MiB;
static_assert(WS_WIN + (size_t)2 * IN_PAD * 1024 * 2 <= WS_WOUT && WS_WKV + (size_t)KVPAD * 1024 * 2 <= WS_WQG && WS_XB + (size_t)T * 1024 * 2 <= WS_R1, "ws map 1");
static_assert(WS_R1 + (size_t)T * ZXLD * 2 <= WS_DT && WS_DT + (size_t)T * 32 * 4 <= WS_XC && WS_XC + (size_t)T * CONVD * 2 <= WS_Y && WS_Y + (size_t)T * DIN * 2 <= WS_MIX, "ws map 2");
static_assert(WS_MIX + (size_t)T * 1024 * 4 <= WS_EIDX && WS_EIDX + (size_t)T * 128 * 4 <= WS_GATE && WS_GATE + (size_t)T * 128 * 4 <= WS_T8, "ws map 3");
static_assert(WS_KS + (size_t)SBT * SKVP * 1024 * 2 <= WS_VS && WS_VS + (size_t)SBT * SKVP * 1024 * 2 <= WS_LOGF && WS_LOGF + (size_t)T * 16 * 4 <= WS_BIASP && WS_BIASP + (size_t)PB * AH * PL * 4 <= WS_BIASS && WS_BIASS + (size_t)SBT * AH * SKVP * 4 <= WS_KVEND && WS_KVEND <= 819 * MiB, "ws map 4");
constexpr int CW_TMO = 0, CW_CODE = 1, CW_BAR = 4096, MAX_BAR_REGIONS = 48;
constexpr int CW_HO = 1024, HO_STRIDE = 256, HO_ROWT = 32;
static_assert((CW_BAR + MAX_BAR_REGIONS * XCD_BAR_WORDS) * 4 <= (int)CTL_ZERO_BYTES, "CTL words inside the memset region");

constexpr int RING_OFF = 0, RING_BYTES = 131072;
constexpr int LDSCTL_OFF = RING_BYTES, MISC_OFF = LDSCTL_OFF + 320;
constexpr int LDS_BYTES = 147456;

#define DI __device__ __forceinline__
DI float bf2f(unsigned short u) { return __uint_as_float(((unsigned)u) << 16); }
DI float bflo(unsigned w) { return __uint_as_float(w << 16); }
DI float bfhi(unsigned w) { return __uint_as_float(w & 0xffff0000u); }
DI float silu_f(float v) { return v * __builtin_amdgcn_rcpf(1.f + __builtin_amdgcn_exp2f(-1.4426950408889634f * v)); }
DI float sigmoid_f(float v) { return __builtin_amdgcn_rcpf(1.f + __builtin_amdgcn_exp2f(-1.4426950408889634f * v)); }
DI float softplus_f(float v) { return v > 20.f ? v : log1pf(expf(v)); }
DI float logsigmoid_f(float v) { return v >= 0.f ? -log1pf(expf(-v)) : v - log1pf(expf(v)); }
DI float gelu_erf(float v) { return 0.5f * v * (1.f + erff(v * 0.70710678118654752f)); }
DI float dpp_xor1(float v) { return __builtin_bit_cast(float, __builtin_amdgcn_update_dpp(0, __builtin_bit_cast(int, v), 0xB1, 0xF, 0xF, true)); }
DI float dpp_xor2(float v) { return __builtin_bit_cast(float, __builtin_amdgcn_update_dpp(0, __builtin_bit_cast(int, v), 0x4E, 0xF, 0xF, true)); }
DI float swz_xor4(float v) { return __builtin_bit_cast(float, __builtin_amdgcn_ds_swizzle(__builtin_bit_cast(int, v), 0x101F)); }
DI float dpp_xor8(float v) { return __builtin_bit_cast(float, __builtin_amdgcn_update_dpp(0, __builtin_bit_cast(int, v), 0x128, 0xF, 0xF, true)); }
DI float swz_xor16(float v) { return __builtin_bit_cast(float, __builtin_amdgcn_ds_swizzle(__builtin_bit_cast(int, v), 0x401F)); }
DI float xor32(float v) { const auto r = __builtin_amdgcn_permlane32_swap(__float_as_uint(v), __float_as_uint(v), false, false); return __uint_as_float((threadIdx.x & 32) ? r[0] : r[1]); }
DI float wave_sum(float v) { v += dpp_xor1(v); v += dpp_xor2(v); v += swz_xor4(v); v += dpp_xor8(v); v += swz_xor16(v); v += xor32(v); return v; }
DI float wave_max(float v) { v = fmaxf(v, dpp_xor1(v)); v = fmaxf(v, dpp_xor2(v)); v = fmaxf(v, swz_xor4(v)); v = fmaxf(v, dpp_xor8(v)); v = fmaxf(v, swz_xor16(v)); v = fmaxf(v, xor32(v)); return v; }

#ifndef RP_GU
#define RP_GU 1
#endif
#ifndef RP_BAR
#define RP_BAR 1
#endif
#ifndef RP_LN
#define RP_LN 1
#endif
#ifndef RP_PRO
#define RP_PRO 1
#endif
#ifndef RP_KVP
#define RP_KVP 1
#endif
#ifndef RP_GC
#define RP_GC 1
#endif
#ifndef RP_CVT
#define RP_CVT 1
#endif
#ifndef RP_TOPK
#define RP_TOPK 1
#endif
#ifndef RP_GATHER
#define RP_GATHER 1
#endif
#ifndef RP_ATTN
#define RP_ATTN 1
#endif
#ifndef RP_SCAN
#define RP_SCAN 1
#endif
#ifndef RP_CONV
#define RP_CONV 1
#endif
#ifndef RP_GEMM
#define RP_GEMM 1
#endif
struct Ctx {
    LAS unsigned char* lds;
    int tid, lane, wave, vcu, G, bx;
};
struct Args { const float* in[25]; float* out; unsigned char* ws; int ph_lo, ph_hi, li, pad; };
typedef const __attribute__((address_space(4))) Args* CArgs;
DI Ctx mkctx(LAS unsigned char* lds) {
    Ctx c; int tid = threadIdx.x, G = gridDim.x, bx = blockIdx.x; asm volatile("" : "+v"(tid), "+s"(G), "+s"(bx));
    c.lds = lds; c.tid = tid; c.lane = tid & 63; c.wave = __builtin_amdgcn_readfirstlane(tid >> 6); c.G = G; c.vcu = (G % 8 == 0) ? (bx % 8) * (G / 8) + bx / 8 : bx; c.bx = bx;
    return c;
}
DI CArgs kargs() { CArgs p = (CArgs)__builtin_amdgcn_kernarg_segment_ptr(); asm volatile("" : "+s"(p)); return p; }

namespace pg8 {
struct EpiInproj {
    static constexpr bool PERM = true, AFTER_DRAIN = false;
    bf16_t* ZX; float* DT;
    __device__ __forceinline__ void operator()(const f32x4 (&acc)[2][2][4][2], const Unit& u, int wr, int wc, int fr, int fq) const {
        const int row0 = u.pm * BM + wr * 64 + fr;
        if (u.pn < 20) {
            const int col0 = u.pn * BM + wc * 32 + 8 * fq;
#pragma unroll
            for (int ai = 0; ai < 2; ++ai)
#pragma unroll
                for (int m = 0; m < 4; ++m) { bf16_t* rowp = ZX + (size_t)(row0 + ai * HALF + m * 16) * ZXLD + col0;
#pragma unroll
                    for (int bj = 0; bj < 2; ++bj) { const f32x4 v0 = acc[ai][bj][m][0], v1 = acc[ai][bj][m][1];
                        u32x4 w; w.x = cvt_pk_bf16(v0[0], v0[1]); w.y = cvt_pk_bf16(v0[2], v0[3]); w.z = cvt_pk_bf16(v1[0], v1[1]); w.w = cvt_pk_bf16(v1[2], v1[3]);
                        *(u32x4*)(rowp + bj * HALF) = w; } }
        } else if (wc == 0) {
#pragma unroll
            for (int ai = 0; ai < 2; ++ai)
#pragma unroll
                for (int m = 0; m < 4; ++m) { float* rp = DT + (size_t)(row0 + ai * HALF + m * 16) * 32 + 8 * fq;
                    *(f32x4*)rp = acc[ai][0][m][0]; *(f32x4*)(rp + 4) = acc[ai][0][m][1]; }
        }
    }
};
struct EpiKV {
    static constexpr bool PERM = true, AFTER_DRAIN = false;
    bf16_t* KP; bf16_t* VP; bf16_t* KS; bf16_t* VS; float* LOGF; float* out;
    __device__ __forceinline__ void operator()(const f32x4 (&acc)[2][2][4][2], const Unit& u, int wr, int wc, int fr, int fq) const {
        const int row0 = u.pm * BM + wr * 64 + fr;
        const bool prompt = (u.pm * BM) < TP;
        if (u.pn < 8) {
            const bool isv = u.pn >= 4;
            const int colb = (u.pn & 3) * BM + wc * 32 + 8 * fq;
            const size_t np = prompt ? 0u : 1u, iv = isv ? 1u : 0u;
            bf16_t* bb = (bf16_t*)((unsigned char*)KP + np * (WS_KS - WS_KP) + iv * (prompt ? (WS_VP - WS_KP) : (WS_VS - WS_KS)));
            float* fb = out + O_PK + np * (O_SK - O_PK) + iv * (prompt ? (O_PV - O_PK) : (O_SV - O_SK));
#pragma unroll
            for (int ai = 0; ai < 2; ++ai)
#pragma unroll
                for (int m = 0; m < 4; ++m) { const int row = row0 + ai * HALF + m * 16; const int orow = prompt ? row : row - TP;
#pragma unroll
                    for (int bj = 0; bj < 2; ++bj) { const f32x4 v0 = acc[ai][bj][m][0], v1 = acc[ai][bj][m][1]; const int col = colb + bj * HALF;
                        u32x4 w; w.x = cvt_pk_bf16(v0[0], v0[1]); w.y = cvt_pk_bf16(v0[2], v0[3]); w.z = cvt_pk_bf16(v1[0], v1[1]); w.w = cvt_pk_bf16(v1[2], v1[3]);
                        const size_t brow = prompt ? (size_t)row : (size_t)((orow >> 6) * SKVP + PAST + (orow & 63));
                        *(u32x4*)(bb + brow * 1024 + col) = w;
                        float* fp = fb + (size_t)orow * 1024 + col; *(f32x4*)fp = v0; *(f32x4*)(fp + 4) = v1; } }
        } else if (wc == 0 && fq < 2) {
#pragma unroll
            for (int ai = 0; ai < 2; ++ai)
#pragma unroll
                for (int m = 0; m < 4; ++m) { const int row = row0 + ai * HALF + m * 16;
                    *(f32x4*)(LOGF + (size_t)row * 16 + 8 * fq) = acc[ai][0][m][0]; *(f32x4*)(LOGF + (size_t)row * 16 + 8 * fq + 4) = acc[ai][0][m][1]; }
        }
    }
};
}

DI void p0_transpose_item(const float* W, int K, int ld, int Nvalid, int Npad, bf16* WT, LAS float* scr, int item, int lane) {
    const int nblk = Npad / 32, kb = item / nblk, nb = item % nblk, k0 = 64 * kb, n0 = 32 * nb;
    const int n4 = n0 + 4 * (lane & 7);
#pragma unroll
    for (int i = 0; i < 8; ++i) { const int kk = 8 * i + (lane >> 3); f32x4 v = (f32x4){0.f, 0.f, 0.f, 0.f};
        if (n4 + 3 < Nvalid) v = *(const f32x4*)(W + (size_t)(k0 + kk) * ld + n4);
        else { if (n4 < Nvalid) v.x = W[(size_t)(k0 + kk) * ld + n4]; if (n4 + 1 < Nvalid) v.y = W[(size_t)(k0 + kk) * ld + n4 + 1]; if (n4 + 2 < Nvalid) v.z = W[(size_t)(k0 + kk) * ld + n4 + 2]; }
        LAS float* d = scr + kk * 33 + 4 * (lane & 7); d[0] = v.x; d[1] = v.y; d[2] = v.z; d[3] = v.w; }
    LDS_WAIT(); asm volatile("" ::: "memory");
    const int c = lane & 7;
#pragma unroll
    for (int j = 0; j < 4; ++j) { const int n = (lane >> 3) + 8 * j; const LAS float* s = scr + (8 * c) * 33 + n;
        v4u o; o.x = pk2(s[0 * 33], s[1 * 33]); o.y = pk2(s[2 * 33], s[3 * 33]); o.z = pk2(s[4 * 33], s[5 * 33]); o.w = pk2(s[6 * 33], s[7 * 33]);
        *(GAS v4u*)(WT + (size_t)(n0 + n) * K + k0 + 8 * c) = o; }
    LDS_WAIT(); asm volatile("" ::: "memory");
}

struct TrJob { const float* W; int K, ld, Nvalid, Npad; bf16* WT; };

DI void weight_jobs(const Ctx& c, CArgs a, int set, int gw, int NGW) {
    LAS float* scr = (LAS float*)(c.lds + RING_OFF + c.wave * 16384);
    bf16* win = (bf16*)(a->ws + WS_WIN); bf16* wout = (bf16*)(a->ws + WS_WOUT); bf16* wkv = (bf16*)(a->ws + WS_WKV);
    bf16* wqg = (bf16*)(a->ws + WS_WQG); bf16* wo = (bf16*)(a->ws + WS_WO); bf16* wpq = (bf16*)(a->ws + WS_WPQ);
#define TRJOB(Wp, K_, ld_, Nv_, Np_, WTp) do { const int nit = ((K_) / 64) * ((Np_) / 32); for (int it = gw; it < nit; it += NGW) p0_transpose_item((Wp), (K_), (ld_), (Nv_), (Np_), (WTp), scr, it, c.lane); } while (0)
    if (set == 0) {
        TRJOB(a->in[7], 1024, IN_DIM, IN_DIM, IN_PAD, win);
        TRJOB(a->in[14], 2048, 1024, 1024, 1024, wout);
        TRJOB(a->in[19], 1024, 2048, 2048, 2048, wpq);
    } else {
        TRJOB(a->in[7] + (size_t)1024 * IN_DIM, 1024, IN_DIM, IN_DIM, IN_PAD, win + (size_t)IN_PAD * 1024);
        TRJOB(a->in[14] + (size_t)2048 * 1024, 2048, 1024, 1024, 1024, wout + (size_t)1024 * 2048);
        for (int l = 0; l < 2; ++l) {
            TRJOB(a->in[17] + (size_t)l * 1024 * 2048, 1024, 2048, 2048, 2048, wqg + (size_t)l * 2048 * 1024);
            TRJOB(a->in[18] + (size_t)l * 1024 * 1024, 1024, 1024, 1024, 1024, wo + (size_t)l * 1024 * 1024);
        }
        TRJOB(a->in[15], 1024, KVN, KVN, KVPAD, wkv);
        for (int l = 1; l < 4; ++l) TRJOB(a->in[19] + (size_t)l * 1024 * 2048, 1024, 2048, 2048, 2048, wpq + (size_t)l * 2048 * 1024);
    }
#undef TRJOB
}
DI void ph_prologue(const Ctx& c, CArgs a) {
    const int gw = c.vcu * NWAVES + c.wave, NGW = c.G * NWAVES;
    weight_jobs(c, a, 0, gw, NGW);
    { unsigned* ska = (unsigned*)(a->ws + WS_SKT); const float* sk = a->in[20];
      const int gt = (c.vcu * NWAVES + c.wave) * 64 + c.lane, NT = c.G * NWAVES * 64;
      for (int i = gt; i < 4 * 16384; i += NT) { const int e2 = i & 3, ln = (i >> 2) & 63, ks = (i >> 8) & 7, j = (i >> 11) & 3, lk = i >> 13;
          const int n = 32 * j + (ln & 31), d = 16 * ks + 8 * (ln >> 5) + 2 * e2;
          ska[i] = pk2(sk[((size_t)lk * 128 + n) * 128 + d], sk[((size_t)lk * 128 + n) * 128 + d + 1]); } }
    { bf16* xb = (bf16*)(a->ws + WS_XB);
      for (int m = gw; m < T; m += NGW) {
          const float* src = m < TP ? a->in[0] + (size_t)m * DM : a->in[1] + (size_t)(m - TP) * DM;
          const GAS f32x4* xr = (const GAS f32x4*)src + c.lane;
          GAS unsigned long long* o8 = (GAS unsigned long long*)(xb + (size_t)m * DM) + c.lane;
#pragma unroll
          for (int j = 0; j < 4; ++j) { const f32x4 v = xr[64 * j]; o8[64 * j] = (unsigned long long)pk2(v.x, v.y) | ((unsigned long long)pk2(v.z, v.w) << 32); } } }
}

constexpr int NCHUNK = T / 64;
DI void ph_ssdprep(const Ctx& c, CArgs a, int layer) {
    const bf16* ZX = (const bf16*)(a->ws + WS_R1); bf16* XT = (bf16*)(a->ws + WS_XT); unsigned char* IMG = a->ws + WS_IMG;
    const float* cw = a->in[8] + (size_t)layer * 4 * CONVD; const float* cb = a->in[9] + (size_t)layer * CONVD; const float* cst = a->in[3] + (size_t)layer * SBT * 3 * CONVD;
    LAS unsigned short* raw = (LAS unsigned short*)(c.lds + RING_OFF + c.wave * 8704);
    const int gw = c.vcu * NWAVES + c.wave, NGW = c.G * NWAVES, lane = c.lane;
    for (int task = gw; task < NCHUNK * 48; task += NGW) {
        const int ck = task / 48, ct = task % 48, t0 = ck * 64, ch0 = ct * 64;
        const bool sample = ck >= PB * (PL / 64); const bool first = sample || (ck % (PL / 64)) == 0; const int sb = ck - PB * (PL / 64);
#pragma unroll
        for (int i = 0; i < 9; ++i) { const int row = i * 8 + (lane >> 3) - 3, col8 = (lane & 7) * 8;
            if (row < 64) { v4u w;
                if (row >= 0 || !first) w = *(const v4u*)(ZX + (size_t)(t0 + row) * ZXLD + 2048 + ch0 + col8);
                else if (sample) { const float* sp = cst + ((size_t)sb * 3 + (row + 3)) * CONVD + ch0 + col8; const f32x4 s0 = *(const f32x4*)sp, s1 = *(const f32x4*)(sp + 4);
                    w = (v4u){pk2(s0.x, s0.y), pk2(s0.z, s0.w), pk2(s1.x, s1.y), pk2(s1.z, s1.w)}; }
                else w = (v4u){0u, 0u, 0u, 0u};
                *(LAS v4u*)(raw + (row + 3) * 64 + col8) = w; } }
        LDS_WAIT(); asm volatile("" ::: "memory");
        const int ch = ch0 + lane;
        const float w0 = cw[ch], w1 = cw[CONVD + ch], w2 = cw[2 * CONVD + ch], w3 = cw[3 * CONVD + ch], bs = cb[ch];
        float u0 = bf2f(raw[0 * 64 + lane]), u1 = bf2f(raw[1 * 64 + lane]), u2 = bf2f(raw[2 * 64 + lane]);
        unsigned op[32];
#pragma unroll
        for (int s2 = 0; s2 < 32; ++s2) {
            const float ua = bf2f(raw[(2 * s2 + 3) * 64 + lane]), ub = bf2f(raw[(2 * s2 + 4) * 64 + lane]);
            const float va = silu_f(bs + w0 * u0 + w1 * u1 + w2 * u2 + w3 * ua), vb = silu_f(bs + w0 * u1 + w1 * u2 + w2 * ua + w3 * ub);
            op[s2] = pk2(va, vb); u0 = u2; u1 = ua; u2 = ub; }
        LDS_WAIT(); asm volatile("" ::: "memory");
        if (ct < 32) {
            bf16* dst = XT + (((size_t)ck * NH + ct) * 64 + lane) * 64;
#pragma unroll
            for (int q = 0; q < 8; ++q) *(v4u*)(dst + 8 * q) = (v4u){op[4 * q], op[4 * q + 1], op[4 * q + 2], op[4 * q + 3]};
        } else {
            const int cb = ct - 32, isc = cb >> 3, g = (cb & 7) >> 1, nh = cb & 1;
            unsigned char* img = IMG + ((size_t)ck * 4 + g) * SSD_IMG;
            if (!isc) {
#pragma unroll
                for (int q = 0; q < 8; ++q) *(v4u*)(img + 32768 + q * 2048 + (64 * nh + lane) * 16) = (v4u){op[4 * q], op[4 * q + 1], op[4 * q + 2], op[4 * q + 3]}; }
#pragma unroll
            for (int s2 = 0; s2 < 32; ++s2) { raw[(2 * s2) * 64 + lane] = (unsigned short)(op[s2] & 0xffffu); raw[(2 * s2 + 1) * 64 + lane] = (unsigned short)(op[s2] >> 16); }
            LDS_WAIT(); asm volatile("" ::: "memory");
#pragma unroll
            for (int i = 0; i < 8; ++i) *(v4u*)(img + isc * 16384 + (8 * nh + i) * 1024 + lane * 16) = *(const LAS v4u*)(raw + lane * 64 + 8 * i);
            LDS_WAIT(); asm volatile("" ::: "memory");
        }
    }
    { const int gt = gw * 64 + lane, NT = NGW * 64;
      for (int idx = gt; idx < (PB + SBT) * 3 * CONVD; idx += NT) {
          const int ch = idx % CONVD, r = (idx / CONVD) % 3, sq = idx / (3 * CONVD);
          if (sq < PB) { const int row = sq * PL + PL - 3 + r; a->out[O_PCONV + (((size_t)layer * PB + sq) * 3 + r) * CONVD + ch] = bf2f(ZX[(size_t)row * ZXLD + 2048 + ch]); }
          else { const int b = sq - PB; const int row = TP + b * SL + SL - 3 + r; a->out[O_SCONV + (((size_t)layer * SBT + b) * 3 + r) * CONVD + ch] = bf2f(ZX[(size_t)row * ZXLD + 2048 + ch]); } } }
}

typedef float f32x16v __attribute__((ext_vector_type(16)));
typedef unsigned u32x2v __attribute__((ext_vector_type(2)));
DI int crow16(int r, int hi) { return (r & 3) + 8 * (r >> 2) + 4 * hi; }
DI bf16x8 pack8(float v0, float v1, float v2, float v3, float v4, float v5, float v6, float v7) { v4u w; w.x = pg8::cvt_pk_bf16(v0, v1); w.y = pg8::cvt_pk_bf16(v2, v3); w.z = pg8::cvt_pk_bf16(v4, v5); w.w = pg8::cvt_pk_bf16(v6, v7); return __builtin_bit_cast(bf16x8, w); }
DI bf16x8 ld2x8(const bf16* p) { const u32x2v lo = *(const u32x2v*)p, hi2 = *(const u32x2v*)(p + 8); return __builtin_bit_cast(bf16x8, (v4u){lo.x, lo.y, hi2.x, hi2.y}); }
#define SSD_MFMA(A_, B_, C_) __builtin_amdgcn_mfma_f32_32x32x16_bf16((A_), (B_), (C_), 0, 0, 0)
constexpr int SSD_BUF = 49152, SSD_VEC = 2 * SSD_BUF;
DI void ssd_wg_unit(const Ctx& c, CArgs a, int layer, bool sample, int b, int g, int hq) {
    const bf16* XT = (const bf16*)(a->ws + WS_XT); const char* IMGg = (const char*)(a->ws + WS_IMG);
    const float* DT = (const float*)(a->ws + WS_DT); bf16* Y = (bf16*)(a->ws + WS_Y);
    const int lane = c.lane, r32 = lane & 31, hi = lane >> 5, wave = c.wave, head = g * 8 + hq * 4 + (wave >> 1), ph = wave & 1;
    const int row0 = sample ? TP + b * SL : b * PL, nchunk = sample ? 1 : PL / 64, ck0 = row0 / 64;
    const float Ah = -expf(a->in[11][layer * NH + head]), dtb = a->in[10][layer * NH + head], Dh = a->in[12][layer * NH + head];
    LAS float* lv = (LAS float*)(c.lds + RING_OFF + SSD_VEC + wave * 1024);
    LAS float* Ldt = lv; LAS float* Lacs = lv + 64; LAS float* Lw2 = lv + 128; LAS float* Le = lv + 192;
    const unsigned ldsb = (unsigned)(size_t)(c.lds + RING_OFF);
#define SSD_DMA(t0_, ck_, bsel_) do { const char* ib_ = IMGg + ((size_t)(ck_) * 4 + g) * SSD_IMG + lane * 16; \
        _Pragma("unroll") for (int pc_ = 0; pc_ < 6; ++pc_) { const int P_ = wave + 8 * (pc_ & 1); \
            const unsigned dst_ = (pc_ < 4) ? (pc_ >> 1) * 16384 + P_ * 1024 : 32768 + (P_ & 7) * 2048 + (P_ >> 3) * 1024;        \
            attn_body::glds16(ib_ + dst_, (unsigned)__builtin_amdgcn_readfirstlane(ldsb + (bsel_) * SSD_BUF + dst_)); } } while (0)
    f32x16v H[4];
    if (sample) { const float* sp = a->in[2] + (((size_t)layer * SBT + b) * NH + head) * 8192 + (size_t)(32 * ph + r32) * 128;
#pragma unroll
        for (int nt = 0; nt < 4; ++nt)
#pragma unroll
            for (int q = 0; q < 4; ++q) { const f32x4 v = *(const f32x4*)(sp + 32 * nt + 8 * q + 4 * hi); H[nt][4 * q] = v.x; H[nt][4 * q + 1] = v.y; H[nt][4 * q + 2] = v.z; H[nt][4 * q + 3] = v.w; } }
    else {
#pragma unroll
        for (int nt = 0; nt < 4; ++nt) H[nt] = f32x16v{}; }
    bf16x8 XFn[2][2]; float dtn;
#define SSD_LDX(ck_, t0_) do { const bf16* xtp_ = XT + (((size_t)(ck_) * NH + head) * 64 + 32 * ph + r32) * 64; \
        _Pragma("unroll") for (int st = 0; st < 2; ++st) _Pragma("unroll") for (int sp = 0; sp < 2; ++sp) XFn[st][sp] = ld2x8(xtp_ + 32 * st + 16 * sp + 4 * hi); \
        dtn = DT[(size_t)((t0_) + lane) * 32 + head]; } while (0)
    asm volatile("s_waitcnt vmcnt(0) lgkmcnt(0)\n\ts_barrier" ::: "memory");
    SSD_DMA(row0, ck0, 0); SSD_LDX(ck0, row0);
    asm volatile("s_waitcnt vmcnt(0)" ::: "memory");
    for (int ci = 0; ci < nchunk; ++ci) {
        const int t0 = row0 + ci * 64;
        asm volatile("s_waitcnt vmcnt(24) lgkmcnt(0)\n\ts_barrier" ::: "memory");
        asm volatile("" : "+v"(XFn[0][0]), "+v"(XFn[0][1]), "+v"(XFn[1][0]), "+v"(XFn[1][1]), "+v"(dtn));
        bf16x8 XF[2][2];
#pragma unroll
        for (int st = 0; st < 2; ++st)
#pragma unroll
            for (int sp = 0; sp < 2; ++sp) XF[st][sp] = XFn[st][sp];
        const float dtraw = dtn;
        if (ci + 1 < nchunk) { SSD_DMA(t0 + 64, ck0 + ci + 1, (ci + 1) & 1); SSD_LDX(ck0 + ci + 1, t0 + 64); }
        LAS const char* Bs = (LAS const char*)(c.lds + RING_OFF + (ci & 1) * SSD_BUF); LAS const char* Cs = Bs + 16384; LAS const char* BTs = Bs + 32768;
        const int lb16 = hi * 1024 + r32 * 16, lb8 = r32 * 16 + 8 * hi;
        float tot;
        { const float vv = dtraw + dtb, ev = __builtin_amdgcn_exp2f(vv * 1.4426950408889634f);
          const float dtv = vv > 15.f ? vv : (vv < -6.f ? ev - 0.5f * ev * ev : __builtin_amdgcn_logf(1.f + ev) * 0.6931471805599453f);
          float acs = dtv * (Ah * 1.4426950408889634f);
#pragma unroll
          for (int o = 1; o < 64; o <<= 1) { const float v = __shfl_up(acs, o); if (lane >= o) acs += v; }
          tot = __shfl(acs, 63);
          Ldt[lane] = dtv; Lacs[lane] = acs; Lw2[lane] = dtv * __builtin_amdgcn_exp2f(tot - acs); Le[lane] = __builtin_amdgcn_exp2f(acs); }
        LDS_WAIT(); asm volatile("" ::: "memory");
        bf16x8 MA00[2], MA01[2], MA11[2];
        { const float al0 = Lacs[r32], al1 = Lacs[32 + r32];
#define SSD_ST(MA_, sto_, lto_, al_, MASK_) do { f32x16v ST_ = f32x16v{}; \
            _Pragma("unroll") for (int ks = 0; ks < 8; ++ks) ST_ = SSD_MFMA(*(LAS const bf16x8*)(Bs + lb16 + ks * 2048 + (sto_) * 16), *(LAS const bf16x8*)(Cs + lb16 + ks * 2048 + (lto_) * 16), ST_); \
            float m_[16]; \
            _Pragma("unroll") for (int q = 0; q < 4; ++q) { const f32x4 xa = *(const LAS f32x4*)(Lacs + (sto_) + 8 * q + 4 * hi), xd = *(const LAS f32x4*)(Ldt + (sto_) + 8 * q + 4 * hi); \
                _Pragma("unroll") for (int i = 0; i < 4; ++i) { const int r = 4 * q + i; const float v = ST_[r] * __builtin_amdgcn_exp2f((al_) - xa[i]) * xd[i]; m_[r] = ((MASK_) && crow16(r, hi) > r32) ? 0.f : v; } } \
            MA_[0] = pack8(m_[0], m_[1], m_[2], m_[3], m_[4], m_[5], m_[6], m_[7]); MA_[1] = pack8(m_[8], m_[9], m_[10], m_[11], m_[12], m_[13], m_[14], m_[15]); } while (0)
          SSD_ST(MA00, 0, 0, al0, true); SSD_ST(MA01, 0, 32, al1, false); SSD_ST(MA11, 32, 32, al1, true);
#undef SSD_ST
        }
        f32x16v Y0 = f32x16v{}, Y1 = f32x16v{};
#pragma unroll
        for (int nt = 0; nt < 4; ++nt)
#pragma unroll
            for (int st = 0; st < 2; ++st) { const bf16x8 hb = pack8(H[nt][8 * st], H[nt][8 * st + 1], H[nt][8 * st + 2], H[nt][8 * st + 3], H[nt][8 * st + 4], H[nt][8 * st + 5], H[nt][8 * st + 6], H[nt][8 * st + 7]);
                const int c1 = 4 * nt + 2 * st;
                const u32x2v p0 = *(LAS const u32x2v*)(Cs + lb8 + c1 * 1024), p1 = *(LAS const u32x2v*)(Cs + lb8 + (c1 + 1) * 1024), p2 = *(LAS const u32x2v*)(Cs + lb8 + c1 * 1024 + 512), p3 = *(LAS const u32x2v*)(Cs + lb8 + (c1 + 1) * 1024 + 512);
                Y0 = SSD_MFMA(__builtin_bit_cast(bf16x8, (v4u){p0.x, p0.y, p1.x, p1.y}), hb, Y0); Y1 = SSD_MFMA(__builtin_bit_cast(bf16x8, (v4u){p2.x, p2.y, p3.x, p3.y}), hb, Y1); }
#pragma unroll
        for (int q = 0; q < 4; ++q) { const f32x4 e0 = *(const LAS f32x4*)(Le + 8 * q + 4 * hi), e1 = *(const LAS f32x4*)(Le + 32 + 8 * q + 4 * hi);
#pragma unroll
            for (int i = 0; i < 4; ++i) { Y0[4 * q + i] *= e0[i]; Y1[4 * q + i] *= e1[i]; } }
#pragma unroll
        for (int sp = 0; sp < 2; ++sp) { Y0 = SSD_MFMA(MA00[sp], XF[0][sp], Y0); Y1 = SSD_MFMA(MA01[sp], XF[0][sp], Y1); Y1 = SSD_MFMA(MA11[sp], XF[1][sp], Y1); }
#pragma unroll
        for (int sp = 0; sp < 2; ++sp) { const v4u w0 = __builtin_bit_cast(v4u, XF[0][sp]), w1 = __builtin_bit_cast(v4u, XF[1][sp]); const unsigned ww0[4] = {w0.x, w0.y, w0.z, w0.w}, ww1[4] = {w1.x, w1.y, w1.z, w1.w};
#pragma unroll
            for (int i = 0; i < 4; ++i) { Y0[8 * sp + 2 * i] += Dh * bflo(ww0[i]); Y0[8 * sp + 2 * i + 1] += Dh * bfhi(ww0[i]); Y1[8 * sp + 2 * i] += Dh * bflo(ww1[i]); Y1[8 * sp + 2 * i + 1] += Dh * bfhi(ww1[i]); } }
        { bf16* yb = Y + (size_t)t0 * DIN + head * 64 + 32 * ph;
          int lo_ = r32 + 4 * hi * DIN; asm volatile("" : "+v"(lo_));
#pragma unroll
          for (int r = 0; r < 16; r += 2) { const unsigned w0 = pg8::cvt_pk_bf16(Y0[r], Y0[r + 1]), w1 = pg8::cvt_pk_bf16(Y1[r], Y1[r + 1]);
              const int o0 = lo_ + ((r & 3) + 8 * (r >> 2)) * DIN, o1 = lo_ + (((r + 1) & 3) + 8 * ((r + 1) >> 2)) * DIN;
              yb[o0] = (bf16)(w0 & 0xffffu); yb[o1] = (bf16)(w0 >> 16); yb[o0 + 32 * DIN] = (bf16)(w1 & 0xffffu); yb[o1 + 32 * DIN] = (bf16)(w1 >> 16); } }
        { const float dec = __builtin_amdgcn_exp2f(tot);
#pragma unroll
          for (int nt = 0; nt < 4; ++nt) H[nt] = H[nt] * dec;
#pragma unroll
          for (int st = 0; st < 2; ++st)
#pragma unroll
              for (int sp = 0; sp < 2; ++sp) {
                  const int s0 = 32 * st + 16 * sp + 4 * hi; const v4u xw = __builtin_bit_cast(v4u, XF[st][sp]); const f32x4 wa = *(const LAS f32x4*)(Lw2 + s0), wb = *(const LAS f32x4*)(Lw2 + s0 + 8);
                  const bf16x8 x2 = pack8(bflo(xw.x) * wa.x, bfhi(xw.x) * wa.y, bflo(xw.y) * wa.z, bfhi(xw.y) * wa.w, bflo(xw.z) * wb.x, bfhi(xw.z) * wb.y, bflo(xw.w) * wb.z, bfhi(xw.w) * wb.w);
                  const int cb = 4 * st + 2 * sp;
#pragma unroll
                  for (int nt = 0; nt < 4; ++nt) {
                      const u32x2v p0 = *(LAS const u32x2v*)(BTs + lb8 + cb * 2048 + nt * 512), p1 = *(LAS const u32x2v*)(BTs + lb8 + (cb + 1) * 2048 + nt * 512);
                      H[nt] = SSD_MFMA(__builtin_bit_cast(bf16x8, (v4u){p0.x, p0.y, p1.x, p1.y}), x2, H[nt]); } } }
    }
#undef SSD_DMA
#undef SSD_LDX
    { float* op = a->out + (sample ? O_SSSM + (((size_t)layer * SBT + b) * NH + head) * 8192 : O_PSSM + (((size_t)layer * PB + b) * NH + head) * 8192) + (size_t)(32 * ph + r32) * 128;
#pragma unroll
      for (int nt = 0; nt < 4; ++nt)
#pragma unroll
          for (int q = 0; q < 4; ++q) *(f32x4*)(op + 32 * nt + 8 * q + 4 * hi) = (f32x4){H[nt][4 * q], H[nt][4 * q + 1], H[nt][4 * q + 2], H[nt][4 * q + 3]}; }
}
DI void ph_tblcvt(const Ctx& c, CArgs a, int layer, int gw, int NGW, int row_lo = 0, int row_hi = 2 * NEXP);
DI void ph_scan(const Ctx& c, CArgs a, int layer) {
    for (int e = c.bx; e < 256; e += c.G) {
        const bool sample = (e & 1) != 0; const int nrep = sample ? 2 : 1;
        for (int k = 0; k < nrep; ++k) { const int u = sample ? (e >> 1) * 2 + k : (e >> 1); ssd_wg_unit(c, a, layer, sample, u >> 3, (u >> 1) & 3, u & 1); }
    }
    asm volatile("s_waitcnt vmcnt(0) lgkmcnt(0)\n\ts_barrier" ::: "memory");
    { const bool helper = (c.G >= 2) ? (c.bx & 1) != 0 : true; const int hw = ((c.G >= 2) ? (c.bx >> 1) : 0) * NWAVES + c.wave, nhw = ((c.G >= 2) ? (c.G >> 1) : 1) * NWAVES;
      if (helper) { if (layer == 0) weight_jobs(c, a, 1, hw, nhw); ph_tblcvt(c, a, layer, hw, nhw); if (layer == 1) ph_tblcvt(c, a, 2, hw, nhw); } }
}

DI void ph_gnorm(const Ctx& c, CArgs a, int layer) {
    const bf16* ZX = (const bf16*)(a->ws + WS_R1); bf16* Y = (bf16*)(a->ws + WS_Y); const float* nw = a->in[13] + (size_t)layer * DIN;
    const int gw = c.vcu * NWAVES + c.wave, NGW = c.G * NWAVES, ch0 = c.lane * 32;
    for (int m = gw; m < T; m += NGW) {
        float hv[32]; float ss = 0.f;
#pragma unroll
        for (int q = 0; q < 4; ++q) { const v4u wy = *(const v4u*)(Y + (size_t)m * DIN + ch0 + 8 * q), wz = *(const v4u*)(ZX + (size_t)m * ZXLD + ch0 + 8 * q);
            const unsigned yy[4] = {wy.x, wy.y, wy.z, wy.w}, zz[4] = {wz.x, wz.y, wz.z, wz.w};
#pragma unroll
            for (int i = 0; i < 4; ++i) { const float a = bflo(yy[i]) * silu_f(bflo(zz[i])), b = bfhi(yy[i]) * silu_f(bfhi(zz[i])); hv[8 * q + 2 * i] = a; hv[8 * q + 2 * i + 1] = b; ss += a * a + b * b; } }
        ss += dpp_xor1(ss); ss += dpp_xor2(ss); ss += swz_xor4(ss); ss += dpp_xor8(ss);
        const float rstd = 1.f / sqrtf(ss * (1.f / 512.f) + RMS_EPS);
#pragma unroll
        for (int q = 0; q < 4; ++q) { const f32x4 w0 = *(const f32x4*)(nw + ch0 + 8 * q), w1 = *(const f32x4*)(nw + ch0 + 8 * q + 4);
            v4u o; o.x = pk2(hv[8 * q] * rstd * w0.x, hv[8 * q + 1] * rstd * w0.y); o.y = pk2(hv[8 * q + 2] * rstd * w0.z, hv[8 * q + 3] * rstd * w0.w);
            o.z = pk2(hv[8 * q + 4] * rstd * w1.x, hv[8 * q + 5] * rstd * w1.y); o.w = pk2(hv[8 * q + 6] * rstd * w1.z, hv[8 * q + 7] * rstd * w1.w);
            *(v4u*)(Y + (size_t)m * DIN + ch0 + 8 * q) = o; }
    }
}

template <int NR> DI void ln_rows(const Ctx& c, CArgs a, const int (&m)[NR], const bool (&ok)[NR], const bf16* R, const bf16* xin, bf16* xb, const float* g, const float* be, bool last, bool quant) {
    unsigned long long xw[NR][4], rw[NR][4];
#pragma unroll
    for (int k = 0; k < NR; ++k) { const GAS unsigned long long* xr = (const GAS unsigned long long*)(xin + (size_t)m[k] * DM) + c.lane; const GAS unsigned long long* rr = (const GAS unsigned long long*)(R + (size_t)m[k] * DM) + c.lane;
#pragma unroll
        for (int j = 0; j < 4; ++j) { xw[k][j] = ok[k] ? xr[64 * j] : 0ull; rw[k][j] = ok[k] ? rr[64 * j] : 0ull; } }
    f32x4 gg[4], bb[4];
#pragma unroll
    for (int j = 0; j < 4; ++j) { gg[j] = *((const f32x4*)g + 64 * j + c.lane); bb[j] = *((const f32x4*)be + 64 * j + c.lane); }
    f32x4 v[NR][4]; float s[NR], s2[NR];
#pragma unroll
    for (int k = 0; k < NR; ++k) { s[k] = 0.f;
#pragma unroll
        for (int j = 0; j < 4; ++j) { const unsigned long long x_ = xw[k][j], r_ = rw[k][j];
            const f32x4 xv = (f32x4){bflo((unsigned)x_), bfhi((unsigned)x_), bflo((unsigned)(x_ >> 32)), bfhi((unsigned)(x_ >> 32))}, rv = (f32x4){bflo((unsigned)r_), bfhi((unsigned)r_), bflo((unsigned)(r_ >> 32)), bfhi((unsigned)(r_ >> 32))};
            v[k][j] = xv * DN_ALPHA + rv; s[k] += (v[k][j].x + v[k][j].y) + (v[k][j].z + v[k][j].w); } }
#pragma unroll
    for (int k = 0; k < NR; ++k) { const float mean = wave_sum(s[k]) * (1.f / DM); s2[k] = 0.f;
#pragma unroll
        for (int j = 0; j < 4; ++j) { v[k][j] = v[k][j] - mean; s2[k] += (v[k][j].x * v[k][j].x + v[k][j].y * v[k][j].y) + (v[k][j].z * v[k][j].z + v[k][j].w * v[k][j].w); } }
#pragma unroll
    for (int k = 0; k < NR; ++k) {
        const float rstd = 1.f / sqrtf(wave_sum(s2[k]) * (1.f / DM) + LN_EPS);
        GAS unsigned long long* o8 = (GAS unsigned long long*)(xb + (size_t)m[k] * DM) + c.lane; GAS f32x4* of = (GAS f32x4*)(a->out + O_Y + (size_t)m[k] * DM) + c.lane;
#pragma unroll
        for (int j = 0; j < 4; ++j) { const f32x4 o = v[k][j] * rstd * gg[j] + bb[j]; v[k][j] = o;
            if (ok[k]) { if (last) of[64 * j] = o; else o8[64 * j] = (unsigned long long)pk2(o.x, o.y) | ((unsigned long long)pk2(o.z, o.w) << 32); } }
        if (quant) {
            float am = 0.f;
#pragma unroll
            for (int j = 0; j < 4; ++j) am = fmaxf(am, fmaxf(fmaxf(fabsf(v[k][j].x), fabsf(v[k][j].y)), fmaxf(fabsf(v[k][j].z), fabsf(v[k][j].w))));
            am = wave_max(am); const float sc = am > 0.f ? 127.f / am : 1.f;
            unsigned* xq = (unsigned*)(a->ws + WS_XQ) + (size_t)m[k] * (DM / 4) + c.lane;
            if (ok[k]) {
#pragma unroll
                for (int j = 0; j < 4; ++j) { const int q0 = __float2int_rn(v[k][j].x * sc), q1 = __float2int_rn(v[k][j].y * sc), q2 = __float2int_rn(v[k][j].z * sc), q3 = __float2int_rn(v[k][j].w * sc);
                    xq[64 * j] = (unsigned)(q0 & 0xff) | ((unsigned)(q1 & 0xff) << 8) | ((unsigned)(q2 & 0xff) << 16) | ((unsigned)(q3 & 0xff) << 24); }
                if (c.lane == 0) ((float*)(a->ws + WS_SX))[m[k]] = am > 0.f ? am * (1.f / 127.f) : 1.f;
            }
        }
    }
}
#ifndef LN_NR
#define LN_NR 4
#endif
DI void ph_ln(const Ctx& c, CArgs a, int layer, int which, bool dry = false) {
    const bf16* R = (const bf16*)(a->ws + WS_MIX); const bf16* xin = (const bf16*)(a->ws + WS_XB); bf16* xb = (bf16*)(a->ws + (dry ? WS_R1 + 160 * MiB : WS_XB));
    const bool last = (layer == 3 && which == 1 && !dry);
    const float* g = a->in[23] + ((size_t)layer * 2 + which) * DM; const float* be = a->in[24] + ((size_t)layer * 2 + which) * DM;
    const int gw = c.vcu * NWAVES + c.wave, NGW = c.G * NWAVES;
    for (int m0 = gw; m0 < T; m0 += LN_NR * NGW) {
        int m[LN_NR]; bool ok[LN_NR];
#pragma unroll
        for (int k = 0; k < LN_NR; ++k) { const int mk = m0 + k * NGW; ok[k] = mk < T; m[k] = ok[k] ? mk : m0; }
        ln_rows<LN_NR>(c, a, m, ok, R, xin, xb, g, be, last, which == 0 && !dry);
    }
}
DI void ph_ln_handoff(const Ctx& c, CArgs a, int layer, unsigned* ho) {
    static_assert(T == 34816 && DM == 1024, "HandoffOrder and the task table assume 136 x 4 units");
    const bf16* R = (const bf16*)(a->ws + WS_MIX); bf16* xb = (bf16*)(a->ws + WS_XB);
    const float* g = a->in[23] + ((size_t)layer * 2) * DM; const float* be = a->in[24] + ((size_t)layer * 2) * DM;
    volatile LAS unsigned* tkw = (volatile LAS unsigned*)(c.lds + MISC_OFF) + 17;
    for (;;) {
        __syncthreads();
        if (c.tid == 0) {
            const unsigned tk = __hip_atomic_fetch_add(ho, 1u, __ATOMIC_RELAXED, __HIP_MEMORY_SCOPE_AGENT);
            if (tk < 320u) {
                const unsigned rt = tk < 256u ? (tk >> 1) : 128u + ((tk - 256u) >> 3); unsigned sp = 0u;
                while (__hip_atomic_load(ho + HO_ROWT + rt, __ATOMIC_RELAXED, __HIP_MEMORY_SCOPE_AGENT) < 4u) { __builtin_amdgcn_s_sleep(1); if (++sp > (1u << 24)) break; }
                __builtin_amdgcn_fence(__ATOMIC_ACQUIRE, "agent");
                asm volatile("s_waitcnt vmcnt(0)" ::: "memory");
            }
            *tkw = tk;
        }
        __syncthreads();
        const unsigned tk = *tkw;
        if (tk >= 320u) break;
        const int row0 = tk < 256u ? (int)tk * 128 : 32768 + (int)(tk - 256u) * 32, nr = tk < 256u ? 16 : 4;
        for (int i = 0; i < nr; i += 4) { int m[4]; bool ok[4];
#pragma unroll
            for (int k = 0; k < 4; ++k) { m[k] = row0 + (i + k) * NWAVES + c.wave; ok[k] = true; }
            ln_rows<4>(c, a, m, ok, R, xb, xb, g, be, false, true); }
    }
}

DI unsigned f2key(float f) { const unsigned u = __float_as_uint(f); return (u & 0x80000000u) ? ~u : (u | 0x80000000u); }
DI float key2f(unsigned k) { return __uint_as_float((k & 0x80000000u) ? (k & 0x7fffffffu) : ~k); }
#define CE(x, y) do { const unsigned hi_ = (x) > (y) ? (x) : (y), lo_ = (x) > (y) ? (y) : (x); (x) = hi_; (y) = lo_; } while (0)
DI void sort16(unsigned (&v)[16]) { CE(v[0],v[1]); CE(v[2],v[3]); CE(v[0],v[2]); CE(v[1],v[3]); CE(v[1],v[2]); CE(v[4],v[5]); CE(v[6],v[7]); CE(v[4],v[6]); CE(v[5],v[7]); CE(v[5],v[6]); CE(v[0],v[4]); CE(v[2],v[6]); CE(v[2],v[4]); CE(v[1],v[5]); CE(v[3],v[7]); CE(v[3],v[5]); CE(v[1],v[2]); CE(v[3],v[4]); CE(v[5],v[6]); CE(v[8],v[9]); CE(v[10],v[11]); CE(v[8],v[10]); CE(v[9],v[11]); CE(v[9],v[10]); CE(v[12],v[13]); CE(v[14],v[15]); CE(v[12],v[14]); CE(v[13],v[15]); CE(v[13],v[14]); CE(v[8],v[12]); CE(v[10],v[14]); CE(v[10],v[12]); CE(v[9],v[13]); CE(v[11],v[15]); CE(v[11],v[13]); CE(v[9],v[10]); CE(v[11],v[12]); CE(v[13],v[14]); CE(v[0],v[8]); CE(v[4],v[12]); CE(v[4],v[8]); CE(v[2],v[10]); CE(v[6],v[14]); CE(v[6],v[10]); CE(v[2],v[4]); CE(v[6],v[8]); CE(v[10],v[12]); CE(v[1],v[9]); CE(v[5],v[13]); CE(v[5],v[9]); CE(v[3],v[11]); CE(v[7],v[15]); CE(v[7],v[11]); CE(v[3],v[5]); CE(v[7],v[9]); CE(v[11],v[13]); CE(v[1],v[2]); CE(v[3],v[4]); CE(v[5],v[6]); CE(v[7],v[8]); CE(v[9],v[10]); CE(v[11],v[12]); CE(v[13],v[14]); }
DI void merge16(unsigned (&A)[16], const unsigned (&B)[16]) {
#pragma unroll
    for (int i = 0; i < 16; ++i) A[i] = A[i] > B[15 - i] ? A[i] : B[15 - i];
#pragma unroll
    for (int s = 8; s >= 1; s >>= 1)
#pragma unroll
        for (int i = 0; i < 16; ++i) if ((i & s) == 0) CE(A[i], A[i + s]);
}
DI unsigned byte_of(const unsigned (&W)[4], int i) { const int q = i >> 2; const unsigned w = q == 0 ? W[0] : q == 1 ? W[1] : q == 2 ? W[2] : W[3]; return (w >> ((i & 3) * 8)) & 0x7fu; }
DI void ph_topk(const Ctx& c, CArgs a, int layer) {
    const bf16* PQ = (const bf16*)(a->ws + WS_PQ); unsigned short* EIDX = (unsigned short*)(a->ws + WS_EIDX); float* GATE = (float*)(a->ws + WS_GATE);
    LAS v4u* ska = (LAS v4u*)(c.lds + RING_OFF);
    { const v4u* src = (const v4u*)(a->ws + WS_SKT) + (size_t)layer * 4096; for (int i = c.tid; i < 4096; i += NWAVES * 64) ska[i] = src[i]; }
    __syncthreads();
    const int gw = c.vcu * NWAVES + c.wave, NGW = c.G * NWAVES, lane = c.lane, r32 = lane & 31, hi = lane >> 5;
    typedef float f32x16 __attribute__((ext_vector_type(16)));
    bf16x8 qn0[8], qn1[8];
#define LDQ(tile_) do { const bf16* qp_ = PQ + (size_t)((tile_) * 32 + r32) * 256 + 8 * hi; _Pragma("unroll") for (int ks = 0; ks < 8; ++ks) { qn0[ks] = *(const bf16x8*)(qp_ + 16 * ks); qn1[ks] = *(const bf16x8*)(qp_ + 128 + 16 * ks); } } while (0)
    if (gw < T * 8 / 32) LDQ(gw);
    for (int tile = gw; tile < T * 8 / 32; tile += NGW) {
        const int prob = tile * 32 + r32;
        unsigned top0[16], top1[16];
        bf16x8 qc0[8], qc1[8];
#pragma unroll
        for (int ks = 0; ks < 8; ++ks) { qc0[ks] = qn0[ks]; qc1[ks] = qn1[ks]; }
#define TOPK_HALF(k, TOP, qf) do { \
            f32x16 acc[4]; \
            _Pragma("unroll") for (int j = 0; j < 4; ++j) { acc[j] = f32x16{}; \
                _Pragma("unroll") for (int ks = 0; ks < 8; ++ks) acc[j] = __builtin_amdgcn_mfma_f32_32x32x16_bf16(__builtin_bit_cast(bf16x8, ska[(((k) * 4 + j) * 8 + ks) * 64 + lane]), qf[ks], acc[j], 0, 0, 0); } \
            __builtin_amdgcn_sched_barrier(0); unsigned v0[16], v1[16], v2[16], v3[16]; \
            _Pragma("unroll") for (int r = 0; r < 16; ++r) { const unsigned kn = (unsigned)((r & 3) + 8 * (r >> 2) + 4 * hi); \
                v0[r] = (f2key(acc[0][r]) & ~0x7fu) | kn; v1[r] = (f2key(acc[1][r]) & ~0x7fu) | (32u + kn); v2[r] = (f2key(acc[2][r]) & ~0x7fu) | (64u + kn); v3[r] = (f2key(acc[3][r]) & ~0x7fu) | (96u + kn); } \
            __builtin_amdgcn_sched_barrier(0); sort16(v0); sort16(v1); __builtin_amdgcn_sched_barrier(0); merge16(v0, v1); __builtin_amdgcn_sched_barrier(0); sort16(v2); sort16(v3); __builtin_amdgcn_sched_barrier(0); merge16(v2, v3); __builtin_amdgcn_sched_barrier(0); merge16(v0, v2); __builtin_amdgcn_sched_barrier(0); \
            _Pragma("unroll") for (int i = 0; i < 16; ++i) v1[i] = (unsigned)__shfl_xor((int)v0[i], 32); \
            merge16(v0, v1); \
            _Pragma("unroll") for (int i = 0; i < 16; ++i) TOP[i] = v0[i]; } while (0)
        TOPK_HALF(0, top0, qc0); asm volatile("" ::: "memory"); __builtin_amdgcn_sched_barrier(0); TOPK_HALF(1, top1, qc1); asm volatile("" ::: "memory"); __builtin_amdgcn_sched_barrier(0);
        if (tile + NGW < T * 8 / 32) LDQ(tile + NGW);
#undef TOPK_HALF
        float f0[16], f1[16]; unsigned W0[4] = {0u, 0u, 0u, 0u}, W1[4] = {0u, 0u, 0u, 0u};
#pragma unroll
        for (int i = 0; i < 16; ++i) { f0[i] = key2f(top0[i] & ~0x7fu); f1[i] = key2f(top1[i] & ~0x7fu); W0[i >> 2] |= (top0[i] & 0x7fu) << ((i & 3) * 8); W1[i >> 2] |= (top1[i] & 0x7fu) << ((i & 3) * 8); }
#define CKEY(i, j) ((f2key(f0[i] + f1[j]) & ~0xffu) | (unsigned)(((i) << 4) | (j)))
        unsigned G0[16], G1[16], G2[16], G3[16];
#pragma unroll
        for (int j = 0; j < 16; ++j) { G0[j] = CKEY(0, j); G1[j] = j < 8 ? CKEY(1, j) : 0u; }
        G2[0] = CKEY(2, 0); G2[1] = CKEY(2, 1); G2[2] = CKEY(2, 2); G2[3] = CKEY(2, 3); G2[4] = CKEY(2, 4); G2[5] = CKEY(3, 0); G2[6] = CKEY(3, 1); G2[7] = CKEY(3, 2); G2[8] = CKEY(3, 3);
        G2[9] = CKEY(4, 0); G2[10] = CKEY(4, 1); G2[11] = CKEY(4, 2); G2[12] = CKEY(5, 0); G2[13] = CKEY(5, 1); G2[14] = CKEY(6, 0); G2[15] = CKEY(6, 1);
        G3[0] = CKEY(7, 0); G3[1] = CKEY(7, 1); G3[2] = CKEY(8, 0); G3[3] = CKEY(9, 0); G3[4] = CKEY(10, 0); G3[5] = CKEY(11, 0); G3[6] = CKEY(12, 0); G3[7] = CKEY(13, 0); G3[8] = CKEY(14, 0); G3[9] = CKEY(15, 0);
#pragma unroll
        for (int i = 10; i < 16; ++i) G3[i] = 0u;
#undef CKEY
        __builtin_amdgcn_sched_barrier(0); merge16(G0, G1); __builtin_amdgcn_sched_barrier(0); sort16(G2); sort16(G3); __builtin_amdgcn_sched_barrier(0); merge16(G2, G3); __builtin_amdgcn_sched_barrier(0); merge16(G0, G2); __builtin_amdgcn_sched_barrier(0);
        float ex[16]; int eo[16]; const float mx = key2f(G0[0] & ~0xffu); float sm = 0.f;
#pragma unroll
        for (int r = 0; r < 16; ++r) { const unsigned code = G0[r] & 0xffu; ex[r] = __expf(key2f(G0[r] & ~0xffu) - mx); sm += ex[r];
            eo[r] = (int)(byte_of(W0, (int)(code >> 4)) * 128u + byte_of(W1, (int)(code & 15u))); }
        const float inv = 1.f / sm;
        if (hi == 0) { unsigned short* ep = EIDX + (size_t)prob * 16;
#pragma unroll
            for (int q = 0; q < 2; ++q) *(v4u*)(ep + 8 * q) = (v4u){(unsigned)eo[8 * q] | ((unsigned)eo[8 * q + 1] << 16), (unsigned)eo[8 * q + 2] | ((unsigned)eo[8 * q + 3] << 16), (unsigned)eo[8 * q + 4] | ((unsigned)eo[8 * q + 5] << 16), (unsigned)eo[8 * q + 6] | ((unsigned)eo[8 * q + 7] << 16)}; }
        else { float* gp = GATE + (size_t)prob * 16;
#pragma unroll
            for (int q = 0; q < 4; ++q) *(f32x4*)(gp + 4 * q) = (f32x4){ex[4 * q] * inv, ex[4 * q + 1] * inv, ex[4 * q + 2] * inv, ex[4 * q + 3] * inv}; }
    }
    __syncthreads();
}
#undef CE

typedef float f32x2v __attribute__((ext_vector_type(2)));
DI void ph_tblcvt(const Ctx& c, CArgs a, int layer, int gw, int NGW, int row_lo, int row_hi) {
    const float* U = a->in[21] + (size_t)layer * NEXP * DM; const float* V = a->in[22] + (size_t)layer * NEXP * DM;
    unsigned char* T8 = a->ws + ((layer & 1) ? WS_T8B : WS_T8); float* SC = (float*)(a->ws + ((layer & 1) ? WS_TSCB : WS_TSC));
    const int lane = c.lane;
    for (int row = row_lo + gw; row < row_hi; row += NGW) {
        const float* src = (row < NEXP ? U + (size_t)row * DM : V + (size_t)(row - NEXP) * DM) + 16 * lane;
        f32x4 v[4]; float am = 0.f, ss = 0.f;
#pragma unroll
        for (int j = 0; j < 4; ++j) { v[j] = *(const f32x4*)(src + 4 * j); am = fmaxf(am, fmaxf(fmaxf(fabsf(v[j].x), fabsf(v[j].y)), fmaxf(fabsf(v[j].z), fabsf(v[j].w)))); ss += (v[j].x * v[j].x + v[j].y * v[j].y) + (v[j].z * v[j].z + v[j].w * v[j].w); }
        am = wave_max(am);
        const bool keyrow = row < NEXP; float inv; unsigned w2[2] = {0u, 0u};
        if (keyrow) {
            ss = wave_sum(ss); const float step = fmaxf(0.335f * sqrtf(ss * (1.f / DM)), 1e-30f), rs = 1.f / step; inv = step * (1.f / 16.f);
#pragma unroll
            for (int j = 0; j < 4; ++j) { const float x4[4] = {v[j].x, v[j].y, v[j].z, v[j].w};
#pragma unroll
                for (int i = 0; i < 4; ++i) { const int q = max(-8, min(7, __float2int_rn(x4[i] * rs))); const int el = 4 * j + i, c8 = el & 7, nib = (c8 < 4) ? 2 * c8 : 2 * (c8 - 4) + 1;
                    w2[el >> 3] |= ((unsigned)q & 0xfu) << (4 * nib); } }
        } else {
            const float sc = am > 0.f ? 6.f / am : 1.f; inv = am > 0.f ? am * (1.f / 6.f) : 1.f;
#pragma unroll
            for (int j = 0; j < 4; ++j) { const float x4[4] = {v[j].x * sc, v[j].y * sc, v[j].z * sc, v[j].w * sc};
#pragma unroll
                for (int i = 0; i < 4; ++i) { const float av = fabsf(x4[i]);
                    const unsigned mag = (unsigned)(av >= 0.25f) + (unsigned)(av >= 0.75f) + (unsigned)(av >= 1.25f) + (unsigned)(av >= 1.75f) + (unsigned)(av >= 2.5f) + (unsigned)(av >= 3.5f) + (unsigned)(av >= 5.f);
                    const unsigned code = mag | (x4[i] < 0.f ? 8u : 0u); const int el = 4 * j + i;
                    w2[el >> 3] |= code << (4 * (el & 7)); } }
        }
        { typedef unsigned u32x2t __attribute__((ext_vector_type(2)));
          *(u32x2t*)(T8 + (size_t)(row >> 14) * NEXP * DM + (size_t)(lane >> 4) * NEXP * 128 + (size_t)(row & (NEXP - 1)) * 128 + 8 * (lane & 15)) = (u32x2t){w2[0], w2[1]}; }
        if (lane == 0) SC[2 * (row & (NEXP - 1)) + (row >> 14)] = inv;
    }
}
DI void dec16(const v4u& r, float (&f)[16]) {
    const unsigned w[4] = {r.x, r.y, r.z, r.w};
#pragma unroll
    for (int j = 0; j < 4; ++j) { const f32x2v lo = __builtin_amdgcn_cvt_pk_f32_fp8((int)w[j], false), hi = __builtin_amdgcn_cvt_pk_f32_fp8((int)w[j], true);
        f[4 * j] = lo.x; f[4 * j + 1] = lo.y; f[4 * j + 2] = hi.x; f[4 * j + 3] = hi.y; }
}
DI void dec16p(const v4u& r, f32x2v (&f)[8]) {
    const unsigned w[4] = {r.x, r.y, r.z, r.w};
#pragma unroll
    for (int j = 0; j < 4; ++j) { f[2 * j] = __builtin_amdgcn_cvt_pk_f32_fp8((int)w[j], false); f[2 * j + 1] = __builtin_amdgcn_cvt_pk_f32_fp8((int)w[j], true); }
}
DI void gather_e16(const unsigned short* ep, int (&e)[16]) {
#pragma unroll
    for (int q = 0; q < 2; ++q) { const v4u v = *(const v4u*)(ep + 8 * q); const unsigned w[4] = {v.x, v.y, v.z, v.w};
#pragma unroll
        for (int i = 0; i < 4; ++i) { e[8 * q + 2 * i] = (int)(w[i] & (NEXP - 1)); e[8 * q + 2 * i + 1] = (int)((w[i] >> 16) & (NEXP - 1)); } }
}
DI void gather_rows(const unsigned char* base, const int (&e)[16], v4u (&r)[16]) {
#pragma unroll
    for (int i = 0; i < 16; ++i) r[i] = *(const v4u*)(base + (size_t)e[i] * 128);
}
DI void dec32p(const v4u& r, f32x2v (&f)[16]) {
    const unsigned w[4] = {r.x, r.y, r.z, r.w};
#pragma unroll
    for (int j = 0; j < 4; ++j) { f[4 * j] = __builtin_amdgcn_cvt_scalef32_pk_f32_fp4(w[j], 1.0f, 0); f[4 * j + 1] = __builtin_amdgcn_cvt_scalef32_pk_f32_fp4(w[j], 1.0f, 1);
        f[4 * j + 2] = __builtin_amdgcn_cvt_scalef32_pk_f32_fp4(w[j], 1.0f, 2); f[4 * j + 3] = __builtin_amdgcn_cvt_scalef32_pk_f32_fp4(w[j], 1.0f, 3); }
}
DI void ph_gather_u(const Ctx& c, CArgs a, int layer) {
    const unsigned short* EIDX = (const unsigned short*)(a->ws + WS_EIDX); bf16* PART = (bf16*)(a->ws + WS_PART); const unsigned char* U4 = a->ws + ((layer & 1) ? WS_T8B : WS_T8);
    const int lane = c.lane, j = lane >> 3, seg = lane & 7, c0 = lane & 1, c1 = (lane >> 1) & 1, c2 = (lane >> 2) & 1;
    const bool sl8 = (c.G & 7) == 0; const int nsl = sl8 ? 1 : 4, nloc = sl8 ? (c.G >> 3) : c.G, rank = sl8 ? (c.bx >> 3) : c.bx;
    const int hf = sl8 ? ((c.bx & 7) >> 2) : 0, nh = sl8 ? 2 : 1, Tn = (T - hf + nh - 1) / nh;
    const int tb = rank * NWAVES + c.wave, ts = nloc * NWAVES, nt = tb < Tn ? (Tn - tb + ts - 1) / ts : 0;
#define TOK(k) (hf + nh * (tb + ((k) < nt ? (k) : nt - 1) * ts))
    for (int si = 0; si < nsl; ++si) {
        const int slice = sl8 ? (c.bx & 3) : si;
        const unsigned char* ub = U4 + (size_t)slice * NEXP * 128; const unsigned sego = 16u * (unsigned)seg; const unsigned char* xb = a->ws + WS_XQ + 256 * slice + 32 * seg;
#define LDX(X_, k) do { const v4u* xr_ = (const v4u*)(xb + (size_t)TOK(k) * DM); X_[0] = xr_[0]; X_[1] = xr_[1]; } while (0)
#define LDE(E_, k) do { const v4u* er_ = (const v4u*)(EIDX + (size_t)TOK(k) * 128 + 16 * j); E_[0] = er_[0]; E_[1] = er_[1]; } while (0)
#define ROWS(R_, E_) do { _Pragma("unroll") for (int i = 0; i < 16; ++i) { const unsigned ew_ = E_[i >> 3][(i >> 1) & 3]; const unsigned ei_ = ((i & 1) ? (ew_ >> 16) : ew_) & (NEXP - 1); R_[i] = *(const v4u*)(ub + (ei_ * 128u + sego)); } } while (0)
#define COMPUTE_U(R_, X_, k) do { float d[16]; \
            _Pragma("unroll") for (int i = 0; i < 16; ++i) { const unsigned rw_[4] = {R_[i].x, R_[i].y, R_[i].z, R_[i].w}; int s_ = 0; \
                _Pragma("unroll") for (int q = 0; q < 4; ++q) { s_ = __builtin_amdgcn_sdot4((int)((rw_[q] << 4) & 0xF0F0F0F0u), (int)X_[q >> 1][2 * (q & 1)], s_, false); \
                    s_ = __builtin_amdgcn_sdot4((int)(rw_[q] & 0xF0F0F0F0u), (int)X_[q >> 1][2 * (q & 1) + 1], s_, false); } \
                d[i] = (float)s_; } \
            float n8[8], n4[4], n2[2];     \
            _Pragma("unroll") for (int q = 0; q < 8; ++q) { const float send = c0 ? d[q] : d[q + 8], keep = c0 ? d[q + 8] : d[q]; n8[q] = keep + dpp_xor1(send); } \
            _Pragma("unroll") for (int q = 0; q < 4; ++q) { const float send = c1 ? n8[q] : n8[q + 4], keep = c1 ? n8[q + 4] : n8[q]; n4[q] = keep + dpp_xor2(send); } \
            _Pragma("unroll") for (int q = 0; q < 2; ++q) { const float send = c2 ? n4[q] : n4[q + 2], keep = c2 ? n4[q + 2] : n4[q]; n2[q] = keep + swz_xor4(send); } \
            if ((k) < nt) *(unsigned*)(PART + ((size_t)slice * T + TOK(k)) * 128 + 16 * j + 8 * c0 + 4 * c1 + 2 * c2) = pk2(n2[0], n2[1]); } while (0)
        if (nt > 0) {
            v4u e[2], ra[16], rb[16], xa[2], xc[2];
            LDE(e, 0); LDX(xa, 0); ROWS(ra, e);
            LDE(e, 1); LDX(xc, 1);
            for (int k = 0; k < nt; k += 2) {
                __builtin_amdgcn_sched_barrier(0);
                ROWS(rb, e);
                LDE(e, k + 2);
                __builtin_amdgcn_sched_barrier(0);
                COMPUTE_U(ra, xa, k);
                LDX(xa, k + 2);
                __builtin_amdgcn_sched_barrier(0);
                ROWS(ra, e);
                LDE(e, k + 3);
                __builtin_amdgcn_sched_barrier(0);
                COMPUTE_U(rb, xc, k + 1);
                LDX(xc, k + 3);
            }
        }
#undef COMPUTE_U
#undef LDX
#undef LDE
#undef ROWS
    }
#undef TOK
}
DI void ph_gather_c(const Ctx& c, CArgs a, int layer) {
    const unsigned short* EIDX = (const unsigned short*)(a->ws + WS_EIDX); const float* GATE = (const float*)(a->ws + WS_GATE); const bf16* PART = (const bf16*)(a->ws + WS_PART); bf16* HH = (bf16*)(a->ws + WS_HH);
    typedef float f32x2s __attribute__((ext_vector_type(2))); const f32x2s* SC2 = (const f32x2s*)(a->ws + ((layer & 1) ? WS_TSCB : WS_TSC)); const float* SX = (const float*)(a->ws + WS_SX);
    const int gt = (c.vcu * NWAVES + c.wave) * 64 + c.lane, NT = c.G * NWAVES * 64;
    for (int it = gt; it < T * 16; it += NT) {
        const size_t base = (size_t)it * 8;
        const v4u p0 = *(const v4u*)(PART + base), p1 = *(const v4u*)(PART + (size_t)T * 128 + base), p2 = *(const v4u*)(PART + (size_t)2 * T * 128 + base), p3 = *(const v4u*)(PART + (size_t)3 * T * 128 + base);
        const v4u ev = *(const v4u*)(EIDX + base); const f32x4 g0 = *(const f32x4*)(GATE + base), g1 = *(const f32x4*)(GATE + base + 4);
        const float sx = SX[it >> 4];
        const unsigned ew[4] = {ev.x, ev.y, ev.z, ev.w}, w0[4] = {p0.x, p0.y, p0.z, p0.w}, w1[4] = {p1.x, p1.y, p1.z, p1.w}, w2[4] = {p2.x, p2.y, p2.z, p2.w}, w3[4] = {p3.x, p3.y, p3.z, p3.w};
        const float gt8[8] = {g0.x, g0.y, g0.z, g0.w, g1.x, g1.y, g1.z, g1.w};
        float su[8], sv[8];
#pragma unroll
        for (int q = 0; q < 8; ++q) { const int e = (int)((ew[q >> 1] >> (16 * (q & 1))) & (NEXP - 1)); const f32x2s sc = SC2[e]; su[q] = sc.x; sv[q] = sc.y; }
        float h[8];
#pragma unroll
        for (int q = 0; q < 8; ++q) { const int j = q >> 1;
            const float d = (q & 1) ? ((bfhi(w0[j]) + bfhi(w1[j])) + (bfhi(w2[j]) + bfhi(w3[j]))) : ((bflo(w0[j]) + bflo(w1[j])) + (bflo(w2[j]) + bflo(w3[j])));
            h[q] = gelu_erf(d * su[q] * sx) * gt8[q] * sv[q]; }
        *(v4u*)(HH + base) = (v4u){pk2(h[0], h[1]), pk2(h[2], h[3]), pk2(h[4], h[5]), pk2(h[6], h[7])};
    }
}
DI void ph_gather_v(const Ctx& c, CArgs a, int layer) {
    const unsigned short* EIDX = (const unsigned short*)(a->ws + WS_EIDX); const bf16* HH = (const bf16*)(a->ws + WS_HH); bf16* PE = (bf16*)(a->ws + WS_MIX); const unsigned char* V4 = a->ws + ((layer & 1) ? WS_T8B : WS_T8) + (size_t)NEXP * DM;
    const int lane = c.lane, j = lane >> 3, seg = lane & 7, b3 = (lane >> 3) & 1, b4 = (lane >> 4) & 1, b5 = (lane >> 5) & 1;
    const bool sl8 = (c.G & 7) == 0; const int nsl = sl8 ? 1 : 4, nloc = sl8 ? (c.G >> 3) : c.G, rank = sl8 ? (c.bx >> 3) : c.bx;
    const int hf = sl8 ? ((c.bx & 7) >> 2) : 0, nh = sl8 ? 2 : 1, Tn = (T - hf + nh - 1) / nh;
    const int tb = rank * NWAVES + c.wave, ts = nloc * NWAVES, nt = tb < Tn ? (Tn - tb + ts - 1) / ts : 0;
#define TOK(k) (hf + nh * (tb + ((k) < nt ? (k) : nt - 1) * ts))
    for (int si = 0; si < nsl; ++si) {
        const int slice = sl8 ? (c.bx & 3) : si;
        const unsigned char* vb = V4 + (size_t)slice * NEXP * 128; const unsigned sego = 16u * (unsigned)seg;
#define LDH(H_, k) do { const v4u* hr_ = (const v4u*)(HH + (size_t)TOK(k) * 128 + 16 * j); H_[0] = hr_[0]; H_[1] = hr_[1]; } while (0)
#define LDE(E_, k) do { const v4u* er_ = (const v4u*)(EIDX + (size_t)TOK(k) * 128 + 16 * j); E_[0] = er_[0]; E_[1] = er_[1]; } while (0)
#define ROWS(R_, E_) do { _Pragma("unroll") for (int i = 0; i < 16; ++i) { const unsigned ew_ = E_[i >> 3][(i >> 1) & 3]; const unsigned ei_ = ((i & 1) ? (ew_ >> 16) : ew_) & (NEXP - 1); R_[i] = *(const v4u*)(vb + (ei_ * 128u + sego)); } } while (0)
#define COMPUTE_V(R_, H_, k) do { f32x2v ac2[16]; \
            _Pragma("unroll") for (int q = 0; q < 16; ++q) ac2[q] = (f32x2v){0.f, 0.f}; \
            _Pragma("unroll") for (int i = 0; i < 16; ++i) { f32x2v f[16]; dec32p(R_[i], f); const unsigned hw_ = H_[i >> 3][(i >> 1) & 3]; const float hs = (i & 1) ? bfhi(hw_) : bflo(hw_); const f32x2v hh = (f32x2v){hs, hs}; \
                _Pragma("unroll") for (int q = 0; q < 16; ++q) ac2[q] = __builtin_elementwise_fma(f[q], hh, ac2[q]); } \
            float acc[32], n16[16], n8[8], n4[4]; \
            _Pragma("unroll") for (int q = 0; q < 16; ++q) { acc[2 * q] = ac2[q].x; acc[2 * q + 1] = ac2[q].y; } \
            _Pragma("unroll") for (int q = 0; q < 16; ++q) { const float send = b3 ? acc[q] : acc[q + 16], keep = b3 ? acc[q + 16] : acc[q]; n16[q] = keep + dpp_xor8(send); } \
            _Pragma("unroll") for (int q = 0; q < 8; ++q) { const float send = b4 ? n16[q] : n16[q + 8], keep = b4 ? n16[q + 8] : n16[q]; n8[q] = keep + swz_xor16(send); } \
            _Pragma("unroll") for (int q = 0; q < 4; ++q) { const float send = b5 ? n8[q] : n8[q + 4], keep = b5 ? n8[q + 4] : n8[q]; n4[q] = keep + xor32(send); } \
            if ((k) < nt) { typedef unsigned u32x2t __attribute__((ext_vector_type(2))); \
                *(u32x2t*)(PE + (size_t)TOK(k) * DM + 256 * slice + 32 * seg + 16 * b3 + 8 * b4 + 4 * b5) = (u32x2t){pk2(n4[0], n4[1]), pk2(n4[2], n4[3])}; } } while (0)
        if (nt > 0) {
            v4u e[2], ra[16], rb[16], ha[2], hc[2];
            LDE(e, 0); LDH(ha, 0); ROWS(ra, e);
            LDE(e, 1); LDH(hc, 1);
            for (int k = 0; k < nt; k += 2) {
                __builtin_amdgcn_sched_barrier(0);
                ROWS(rb, e);
                LDE(e, k + 2);
                __builtin_amdgcn_sched_barrier(0);
                COMPUTE_V(ra, ha, k);
                LDH(ha, k + 2);
                __builtin_amdgcn_sched_barrier(0);
                ROWS(ra, e);
                LDE(e, k + 3);
                __builtin_amdgcn_sched_barrier(0);
                COMPUTE_V(rb, hc, k + 1);
                LDH(hc, k + 3);
            }
        }
#undef COMPUTE_V
#undef LDH
#undef LDE
#undef ROWS
    }
#undef TOK
}

DI void ph_kvpost(const Ctx& c, CArgs a) {
    const float* LOGF = (const float*)(a->ws + WS_LOGF); float* BP = (float*)(a->ws + WS_BIASP); float* BS = (float*)(a->ws + WS_BIASS);
    const int gw = c.vcu * NWAVES + c.wave, NGW = c.G * NWAVES, lane = c.lane;
    constexpr float L2E = 1.4426950408889634f;
    for (int task = gw; task < PB * AH + SBT * AH; task += NGW) {
        if (task < PB * AH) {
            const int b = task >> 4, h = task & 15; const float bias = a->in[16][h]; float s = 0.f;
            for (int i = 0; i < 32; ++i) { const size_t r = (size_t)b * PL + lane * 32 + i; const float lf = logsigmoid_f(LOGF[r * 16 + h] + bias); a->out[O_PLOGF + r * 16 + h] = lf; s += lf; }
            float inc = s;
#pragma unroll
            for (int o = 1; o < 64; o <<= 1) { const float v = __shfl_up(inc, o); if (lane >= o) inc += v; }
            float run = inc - s;
            for (int i = 0; i < 32; ++i) { const size_t r = (size_t)b * PL + lane * 32 + i; run += a->out[O_PLOGF + r * 16 + h]; BP[(size_t)task * PL + lane * 32 + i] = -run * L2E; }
        } else {
            const int ts = task - PB * AH, b = ts >> 4, h = ts & 15; const float bias = a->in[16][h]; float s = 0.f;
            for (int i = 0; i < 17; ++i) { const int pos = lane * 17 + i; float lf;
                if (pos < PAST) lf = a->in[6][((size_t)b * PAST + pos) * 16 + h];
                else { const size_t r = (size_t)b * SL + (pos - PAST); lf = logsigmoid_f(LOGF[((size_t)TP + r) * 16 + h] + bias); a->out[O_SLOGF + r * 16 + h] = lf; }
                s += lf; }
            float inc = s;
#pragma unroll
            for (int o = 1; o < 64; o <<= 1) { const float v = __shfl_up(inc, o); if (lane >= o) inc += v; }
            float run = inc - s;
            for (int i = 0; i < 17; ++i) { const int pos = lane * 17 + i; float lf;
                if (pos < PAST) lf = a->in[6][((size_t)b * PAST + pos) * 16 + h]; else lf = a->out[O_SLOGF + ((size_t)b * SL + (pos - PAST)) * 16 + h];
                run += lf; BS[(size_t)ts * SKVP + pos] = -run * L2E; }
            BS[(size_t)ts * SKVP + SKV + lane] = 0.f;
        }
    }
    { bf16* KS = (bf16*)(a->ws + WS_KS); bf16* VS = (bf16*)(a->ws + WS_VS);
      for (int r = gw; r < SBT * (PAST + 64); r += NGW) {
          const int b = r / (PAST + 64), p = r % (PAST + 64);
          if (p < PAST) {
              const float* ks = a->in[4] + ((size_t)b * PAST + p) * 1024 + 16 * lane; const float* vs = a->in[5] + ((size_t)b * PAST + p) * 1024 + 16 * lane;
              v4u ok[2], ov[2];
#pragma unroll
              for (int q = 0; q < 2; ++q) { const f32x4 k0 = *(const f32x4*)(ks + 8 * q), k1 = *(const f32x4*)(ks + 8 * q + 4), v0 = *(const f32x4*)(vs + 8 * q), v1 = *(const f32x4*)(vs + 8 * q + 4);
                  ok[q] = (v4u){pk2(k0.x, k0.y), pk2(k0.z, k0.w), pk2(k1.x, k1.y), pk2(k1.z, k1.w)}; ov[q] = (v4u){pk2(v0.x, v0.y), pk2(v0.z, v0.w), pk2(v1.x, v1.y), pk2(v1.z, v1.w)}; }
              v4u* kd = (v4u*)(KS + ((size_t)b * SKVP + p) * 1024 + 16 * lane); v4u* vd = (v4u*)(VS + ((size_t)b * SKVP + p) * 1024 + 16 * lane);
              kd[0] = ok[0]; kd[1] = ok[1]; vd[0] = ov[0]; vd[1] = ov[1];
          } else {
              const int pz = SKV + (p - PAST); const v4u z = (v4u){0u, 0u, 0u, 0u};
              v4u* kd = (v4u*)(KS + ((size_t)b * SKVP + pz) * 1024 + 16 * lane); v4u* vd = (v4u*)(VS + ((size_t)b * SKVP + pz) * 1024 + 16 * lane);
              kd[0] = z; kd[1] = z; vd[0] = z; vd[1] = z;
          }
      } }
}

DI void ph_attn(const Ctx& c, CArgs a) {
    typedef attn_body::bf16 abf;
    const abf* QB = (const abf*)(a->ws + WS_QB); const abf* GB = (const abf*)(a->ws + WS_GB); abf* OG = (abf*)(a->ws + WS_OG);
    const abf* KP = (const abf*)(a->ws + WS_KP); const abf* VP = (const abf*)(a->ws + WS_VP); const abf* KS = (const abf*)(a->ws + WS_KS); const abf* VS = (const abf*)(a->ws + WS_VS);
    const float* BP = (const float*)(a->ws + WS_BIASP); const float* BS = (const float*)(a->ws + WS_BIASS);
    char* shm = (char*)(c.lds + RING_OFF);
    const int wid = c.wave;
    for (int s = c.vcu; s < PB * AH + SBT * AH; s += c.G) {
        const bool prompt = s < PB * AH; const int ss = prompt ? s : s - PB * AH, b = ss >> 4, h = ss & 15, nq = prompt ? PL / 256 : 1;
        const abf* Kh = (prompt ? KP + (size_t)b * PL * DM : KS + (size_t)b * SKVP * DM) + h * 64; const abf* Vh = (prompt ? VP + (size_t)b * PL * DM : VS + (size_t)b * SKVP * DM) + h * 64;
        const float* bias = prompt ? BP + (size_t)ss * PL : BS + (size_t)ss * SKVP;
        for (int qi = nq - 1; qi >= 0; --qi) {
            const int q0 = prompt ? qi * 256 : SKVP - 256;
            const long row = (prompt ? (long)b * PL + q0 : (long)TP + b * SL - 128) + wid * 32;
            const bool st_ok = prompt || wid == 4 || wid == 5;
            attn_body::attn_unit<20>(q0, QB + row * DM + h * 64, Kh, Vh, GB + row * DM + h * 64, OG + row * DM + h * 64, bias, qi == nq - 1 ? q0 + 256 : 0, st_ok, shm);
        }
    }
}

#ifndef HANDOFF
#define HANDOFF 1
#endif
#ifndef HO_SC1
#define HO_SC1 true
#endif
constexpr int N_PHASES = HANDOFF ? 42 : 46;
__global__ void __launch_bounds__(NWAVES * 64, 2) mk_fwd(Args args_unused) {
    extern __shared__ __attribute__((aligned(16))) unsigned char lds[];
    { const int t0 = threadIdx.x; for (int u = t0; u < (LDS_BYTES - LDSCTL_OFF) / 4; u += NWAVES * 64) ((LAS unsigned*)((LAS unsigned char*)lds + LDSCTL_OFF))[u] = 0u; }
    __syncthreads();
    volatile LAS unsigned* MISC = (volatile LAS unsigned*)((LAS unsigned char*)lds + MISC_OFF);
    int lo, hi; XcdBarrier bar;
    { CArgs a = kargs(); lo = a->ph_lo; hi = a->ph_hi; bar = xcd_barrier_post((unsigned*)(a->ws + WS_CTL) + CW_BAR + (size_t)a->li * XCD_BAR_WORDS, MISC + 8); }
    int pc = 0;
#define PH_BEGIN if (lo <= pc && pc < hi) { CArgs a = kargs(); const Ctx c = mkctx((LAS unsigned char*)lds);
#define PH_END   if (pc + 1 < hi) { for (int rb_ = 0; rb_ < RP_BAR; ++rb_) xcd_barrier(bar); } } ++pc;
#define RING (c.lds + RING_OFF)
#define WSP(T_, off) ((T_*)(a->ws + (off)))

    PH_BEGIN for (int r_ = 0; r_ < RP_PRO; ++r_) ph_prologue(c, a); PH_END

#if HANDOFF
#define LN1_PHASE(layer)
#define HO_GEMM(layer, A_, W_, K_) { unsigned* ho_ = WSP(unsigned, WS_CTL) + CW_HO + HO_STRIDE * (layer); \
                       pg8::Gemm g{A_, W_, T, 1024, K_}; pg8::HandoffOrderT<HO_SC1> S; S.init(c.G, c.bx, ho_ + HO_ROWT, (LAS unsigned*)(c.lds + MISC_OFF) + 16); \
                       pg8::EpiBf16<0, HO_SC1> E{WSP(bf16, WS_MIX), 1024, nullptr, 0, 0, 1.f}; \
                       pg8::gemm_phase<pg8::EpiBf16<0, HO_SC1>, pg8::HandoffOrderT<HO_SC1>, true, true>(RING, g, S, E); \
                       for (int r_ = 1; r_ < RP_LN; ++r_) ph_ln(c, a, layer, 0, true); ph_ln_handoff(c, a, layer, ho_); }
#else
#define LN1_PHASE(layer) PH_BEGIN for (int r_ = 1; r_ < RP_LN; ++r_) ph_ln(c, a, layer, 0, true); ph_ln(c, a, layer, 0); PH_END
#define HO_GEMM(layer, A_, W_, K_) { pg8::Gemm g{A_, W_, T, 1024, K_}; pg8::StaticOrder S; S.init(T, 1024, c.G, c.bx); \
                       pg8::EpiBf16<0> E{WSP(bf16, WS_MIX), 1024, nullptr, 0, 0, 1.f}; \
                       for (int r_ = 0; r_ < RP_GEMM; ++r_) pg8::gemm_phase<pg8::EpiBf16<0>, pg8::StaticOrder, true, true>(RING, g, S, E); }
#endif
#define TAIL_TBLCVT(lo_, hi_) do { const int busy_ = (T / 256) * 8 - 4 * c.G; const bool all_ = busy_ <= 0 || busy_ >= c.G; \
        if (all_ || c.bx >= busy_) ph_tblcvt(c, a, 3, ((all_ ? c.bx : c.bx - busy_)) * NWAVES + c.wave, (all_ ? c.G : c.G - busy_) * NWAVES, lo_, hi_); } while (0)
#define PEER_PHASES(layer) \
        LN1_PHASE(layer) \
        PH_BEGIN { pg8::Gemm g{WSP(const bf16, WS_XB), WSP(const bf16, WS_WPQ) + (size_t)(layer) * 2048 * 1024, T, 2048, 1024}; pg8::StaticOrder S; S.init(T, 2048, c.G, c.bx); \
                   pg8::EpiBf16<0> E{WSP(bf16, WS_PQ), 2048, nullptr, 0, 0, 1.f}; \
                   for (int r_ = 0; r_ < RP_GEMM; ++r_) pg8::gemm_phase<pg8::EpiBf16<0>, pg8::StaticOrder, true, true>(RING, g, S, E); \
                   if ((layer) == 2) TAIL_TBLCVT(NEXP, 2 * NEXP); } PH_END \
        PH_BEGIN for (int r_ = 0; r_ < RP_TOPK; ++r_) ph_topk(c, a, layer); PH_END \
        PH_BEGIN for (int r_ = 0; r_ < RP_GATHER * RP_GU; ++r_) ph_gather_u(c, a, layer); PH_END \
        PH_BEGIN for (int r_ = 0; r_ < RP_GC; ++r_) ph_gather_c(c, a, layer); PH_END \
        PH_BEGIN for (int r_ = 0; r_ < RP_GATHER; ++r_) ph_gather_v(c, a, layer); PH_END \
        PH_BEGIN for (int r_ = 1; r_ < RP_LN; ++r_) ph_ln(c, a, layer, 1, true); ph_ln(c, a, layer, 1); PH_END
#define LAYER_A(layer) \
            PH_BEGIN { pg8::Gemm g{WSP(const bf16, WS_XB), WSP(const bf16, WS_WIN) + (size_t)(layer) * IN_PAD * 1024, T, IN_PAD, 1024}; pg8::StaticOrder S; S.init(T, IN_PAD, c.G, c.bx); \
                       pg8::EpiInproj E{WSP(bf16, WS_R1), WSP(float, WS_DT)}; \
                       for (int r_ = 0; r_ < RP_GEMM; ++r_) pg8::gemm_phase<pg8::EpiInproj, pg8::StaticOrder, true, true>(RING, g, S, E); } PH_END \
            PH_BEGIN for (int r_ = 0; r_ < RP_CONV; ++r_) ph_ssdprep(c, a, layer); PH_END \
            PH_BEGIN for (int r_ = 0; r_ < RP_SCAN; ++r_) ph_scan(c, a, layer); PH_END \
            PH_BEGIN ph_gnorm(c, a, layer); PH_END \
            PH_BEGIN HO_GEMM(layer, WSP(const bf16, WS_Y), WSP(const bf16, WS_WOUT) + (size_t)(layer) * 1024 * 2048, 2048) PH_END \
            PEER_PHASES(layer)
#define LAYER_B(layer) \
            PH_BEGIN if ((layer) == 2) { for (int r_ = 0; r_ < RP_KVP; ++r_) ph_kvpost(c, a); __syncthreads(); } \
                     { pg8::Gemm g{WSP(const bf16, WS_XB), WSP(const bf16, WS_WQG) + (size_t)((layer) - 2) * 2048 * 1024, T, 2048, 1024}; pg8::StaticOrder S; S.init(T, 2048, c.G, c.bx); \
                       pg8::EpiBf16<0> E{WSP(bf16, WS_QB), 1024, nullptr, 1024, (size_t)(WS_GB - WS_QB) / 2, attn_body::C2}; \
                       for (int r_ = 0; r_ < RP_GEMM; ++r_) pg8::gemm_phase<pg8::EpiBf16<0>, pg8::StaticOrder, true, true>(RING, g, S, E); \
                       if ((layer) == 2) TAIL_TBLCVT(0, NEXP); } PH_END \
            PH_BEGIN for (int r_ = 0; r_ < RP_ATTN; ++r_) ph_attn(c, a); PH_END \
            PH_BEGIN HO_GEMM(layer, WSP(const bf16, WS_OG), WSP(const bf16, WS_WO) + (size_t)((layer) - 2) * 1024 * 1024, 1024) PH_END \
            PEER_PHASES(layer)

    LAYER_A(0)
    LAYER_A(1)
    PH_BEGIN { pg8::Gemm g{WSP(const bf16, WS_XB), WSP(const bf16, WS_WKV), T, KVPAD, 1024}; pg8::StaticOrder S; S.init(T, KVPAD, c.G, c.bx);
               pg8::EpiKV E{WSP(bf16, WS_KP), WSP(bf16, WS_VP), WSP(bf16, WS_KS), WSP(bf16, WS_VS), WSP(float, WS_LOGF), a->out};
               for (int r_ = 0; r_ < RP_GEMM; ++r_) pg8::gemm_phase<pg8::EpiKV, pg8::StaticOrder, true, true>(RING, g, S, E); } PH_END
    LAYER_B(2)
    LAYER_B(3)
#undef PH_BEGIN
#undef PH_END
}

#ifndef MK_N_LAUNCHES
#define MK_N_LAUNCHES 1
#endif
extern "C" void kernel_launch(void* const* d_in, const int* in_sizes, int n_in, void* d_out, int out_size, void* d_ws, size_t ws_size, hipStream_t stream) {
    static int grid = 0;
    if (grid == 0) {
        if (n_in != 25 || out_size != (int)O_END || ws_size < WS_END) { fprintf(stderr, "kernel_launch: unexpected shapes: n_in %d out %d ws %zu\n", n_in, out_size, ws_size); grid = -1; return; }
        int dev = 0, cus = 0, per_cu = 0;
        if (hipGetDevice(&dev) != hipSuccess || hipDeviceGetAttribute(&cus, hipDeviceAttributeMultiprocessorCount, dev) != hipSuccess) { grid = -1; return; }
        if (hipFuncSetAttribute((const void*)mk_fwd, hipFuncAttributeMaxDynamicSharedMemorySize, LDS_BYTES) != hipSuccess) { fprintf(stderr, "kernel_launch: hipFuncSetAttribute failed\n"); grid = -1; return; }
        if (hipOccupancyMaxActiveBlocksPerMultiprocessor(&per_cu, (const void*)mk_fwd, NWAVES * 64, LDS_BYTES) != hipSuccess || per_cu < 1) { fprintf(stderr, "kernel_launch: occupancy query says %d\n", per_cu); }
        (void)hipGetLastError();
        grid = cus;
    }
    if (grid < 0) return;
    if (hipMemsetAsync((char*)d_ws + WS_CTL, 0, CTL_ZERO_BYTES, stream) != hipSuccess) return;
    Args a{};
    for (int i = 0; i < 25; ++i) a.in[i] = (const float*)d_in[i];
    a.out = (float*)d_out; a.ws = (unsigned char*)d_ws; a.pad = 0;
    constexpr int NL = MK_N_LAUNCHES;
    static_assert(NL >= 1 && NL <= MAX_BAR_REGIONS && NL <= N_PHASES, "launch count");
    for (int li = 0; li < NL; ++li) {
        a.ph_lo = (int)((long)li * N_PHASES / NL); a.ph_hi = (int)((long)(li + 1) * N_PHASES / NL); a.li = li;
        hipLaunchKernelGGL(mk_fwd, dim3(grid), dim3(NWAVES * 64), LDS_BYTES, stream, a);
        const hipError_t le = hipPeekAtLastError();
        if (le != hipSuccess) { fprintf(stderr, "kernel_launch: launch %d failed: %s\n", li, hipGetErrorName(le)); break; }
    }
}
```
